# Optimizing an MI355X kernel written in HIP

```python
import math
import jax
import jax.numpy as jnp
from jax import lax
import numpy as np

D_MODEL = 2048
BATCH = 8
SEQ = 2048
DEPTH = 2

GRID_W = 64
CTX_LEN = 256
HEAD_DIM = 128
N_MIXERS = 4
GROUP_HEADS = D_MODEL // HEAD_DIM // N_MIXERS
GROUP_WIDTH = GROUP_HEADS * HEAD_DIM
MIX_WIDTH = N_MIXERS * GROUP_WIDTH
GQA_HEADS = GROUP_HEADS
GQA_KV_HEADS = GROUP_HEADS // 2
NA_HEADS = GROUP_HEADS
WIN_ROWS = 8
WIN_COLS = 16
DIFF_HEADS = GROUP_HEADS
DIFF_QK_DIM = HEAD_DIM // 2
SWA_HEADS = GROUP_HEADS
SWA_KV_HEADS = GROUP_HEADS // 2
WINDOW = 128
Q_BLOCK = 128
MLP_HIDDEN = 4 * D_MODEL
N_MOD = 6
ROPE_THETA = 10000.0
NORM_EPS = 1e-6
NEG_INF = -1e30
PROJ_HEADS = (GQA_HEADS, GQA_KV_HEADS, GQA_KV_HEADS, NA_HEADS, NA_HEADS, NA_HEADS, 2 * DIFF_HEADS, 2 * DIFF_HEADS, DIFF_HEADS, SWA_HEADS, SWA_KV_HEADS, SWA_KV_HEADS)
PROJ_DIMS = (HEAD_DIM, HEAD_DIM, HEAD_DIM, HEAD_DIM, HEAD_DIM, HEAD_DIM, DIFF_QK_DIM, DIFF_QK_DIM, HEAD_DIM, HEAD_DIM, HEAD_DIM, HEAD_DIM)
PROJ_WIDTH = sum(h * d for h, d in zip(PROJ_HEADS, PROJ_DIMS))

kernel_name = 'hybrid_parallel_group_flow_block'


def rms_norm(x, g):
    xf = x.astype(jnp.float32)
    y = xf * lax.rsqrt(jnp.mean(xf * xf, axis=-1, keepdims=True) + NORM_EPS)
    return (y * g.astype(jnp.float32)).astype(x.dtype)


def modulate(h, shift, scale):
    return h * (1 + scale) + shift


def axial_rope(n_tok, dim):
    t = jnp.arange(n_tok)
    row = (t // GRID_W).astype(jnp.float32)
    col = (t % GRID_W).astype(jnp.float32)
    n_freq = dim // 4
    inv_freq = ROPE_THETA ** (-jnp.arange(n_freq, dtype=jnp.float32) / n_freq)
    ang = jnp.concatenate([row[:, None] * inv_freq, col[:, None] * inv_freq], axis=-1)
    return jnp.cos(ang), jnp.sin(ang)


def apply_rope(x, cos, sin):
    xf = x.astype(jnp.float32).reshape(*x.shape[:-1], -1, 2)
    x0, x1 = xf[..., 0], xf[..., 1]
    c = cos[None, :, None, :]
    s = sin[None, :, None, :]
    return jnp.stack([x0 * c - x1 * s, x0 * s + x1 * c], axis=-1).reshape(x.shape).astype(x.dtype)


def split_heads(p):
    parts, start = [], 0
    for h, d in zip(PROJ_HEADS, PROJ_DIMS):
        parts.append(p[..., start:start + h * d].reshape(*p.shape[:-1], h, d))
        start += h * d
    return parts


def to_blocks(a, size):
    b, s = a.shape[:2]
    return jnp.swapaxes(a.reshape(b, s // size, size, *a.shape[2:]), 0, 1)


def from_blocks(a):
    nb, b, size = a.shape[:3]
    return jnp.swapaxes(a, 0, 1).reshape(b, nb * size, *a.shape[3:])


def gqa_attend(q, k, v, bias=None, sink=None):
    b, nq, h, d = q.shape
    hkv = k.shape[2]
    g = h // hkv
    qg = q.reshape(b, nq, hkv, g, d)
    s = jnp.einsum('bqhgd,bkhd->bhgqk', qg, k).astype(jnp.float32) * (d ** -0.5)
    if bias is not None:
        s = s + bias
    if sink is not None:
        sk = jnp.broadcast_to(sink.astype(jnp.float32).reshape(1, hkv, g, 1, 1), s.shape[:-1] + (1,))
        p = jax.nn.softmax(jnp.concatenate([s, sk], axis=-1), axis=-1)[..., :-1]
    else:
        p = jax.nn.softmax(s, axis=-1)
    o = jnp.einsum('bhgqk,bkhd->bqhgd', p.astype(v.dtype), v)
    return o.reshape(b, nq, h * v.shape[-1])


def mixer_global_gqa(q, k, v, qc, kc, vc, gq, gk, cos, sin, with_ctx):
    q = apply_rope(rms_norm(q, gq), cos, sin)
    k = apply_rope(rms_norm(k, gk), cos, sin)
    kc = rms_norm(kc, gk)
    k_all = jnp.concatenate([k, kc], axis=1)
    v_all = jnp.concatenate([v, vc], axis=1)
    out = from_blocks(lax.map(lambda qb: gqa_attend(qb, k_all, v_all), to_blocks(q, Q_BLOCK)))
    out_c = gqa_attend(rms_norm(qc, gq), kc, vc) if with_ctx else None
    return out, out_c


def mixer_neighbourhood(q, k, v, qc, kc, vc, rpb, with_ctx):
    b, s, h, d = q.shape
    rows = s // GRID_W
    wr = min(WIN_ROWS, rows)
    wc = min(WIN_COLS, GRID_W)
    n_nb = wr * wc
    scale = d ** -0.5
    k_grid = k.reshape(b, rows, GRID_W, h, d)
    v_grid = v.reshape(b, rows, GRID_W, h, d)
    col = jnp.arange(GRID_W)
    col_idx = jnp.clip(col - wc // 2, 0, GRID_W - wc)[:, None] + jnp.arange(wc)[None, :]
    dcol = col_idx - col[:, None] + WIN_COLS - 1

    def row_block(args):
        r, qr = args
        r_start = jnp.clip(r - wr // 2, 0, rows - wr)
        kr = lax.dynamic_slice_in_dim(k_grid, r_start, wr, axis=1)[:, :, col_idx]
        vr = lax.dynamic_slice_in_dim(v_grid, r_start, wr, axis=1)[:, :, col_idx]
        drow = r_start + jnp.arange(wr) - r + WIN_ROWS - 1
        bias = rpb[:, drow[None, :, None], dcol[:, None, :]].astype(jnp.float32)
        s_nb = jnp.einsum('bqhd,biqjhd->bhqij', qr, kr).astype(jnp.float32) * scale + bias[None]
        s_cx = jnp.einsum('bqhd,bkhd->bhqk', qr, kc).astype(jnp.float32) * scale
        p = jax.nn.softmax(jnp.concatenate([s_nb.reshape(b, h, GRID_W, n_nb), s_cx], axis=-1), axis=-1).astype(v.dtype)
        o = (jnp.einsum('bhqij,biqjhd->bqhd', p[..., :n_nb].reshape(b, h, GRID_W, wr, wc), vr)
             + jnp.einsum('bhqk,bkhd->bqhd', p[..., n_nb:], vc))
        return o.reshape(b, GRID_W, h * d)

    out = from_blocks(lax.map(row_block, (jnp.arange(rows), to_blocks(q, GRID_W))))
    out_c = gqa_attend(qc, kc, vc) if with_ctx else None
    return out, out_c


def diff_attend(q, k, v, lam):
    s = jnp.einsum('bqhd,bkhd->bhqk', q, k).astype(jnp.float32) * (q.shape[-1] ** -0.5)
    a = jax.nn.softmax(s, axis=-1)
    p = (a[:, 0::2] - lam * a[:, 1::2]).astype(v.dtype)
    return jnp.einsum('bhqk,bkhd->bqhd', p, v)


def mixer_diff(q, k, v, qc, kc, vc, lq1, lk1, lq2, lk2, gsub, lam_init, cos, sin, with_ctx):
    f32 = jnp.float32
    lam = (jnp.exp(jnp.sum(lq1.astype(f32) * lk1.astype(f32)))
           - jnp.exp(jnp.sum(lq2.astype(f32) * lk2.astype(f32))) + lam_init)
    q = apply_rope(q, cos, sin)
    k = apply_rope(k, cos, sin)
    k_all = jnp.concatenate([k, kc], axis=1)
    v_all = jnp.concatenate([v, vc], axis=1)

    def post(o):
        return (rms_norm(o, gsub) * (1 - lam_init)).reshape(o.shape[0], o.shape[1], -1)

    out = from_blocks(lax.map(lambda qb: post(diff_attend(qb, k_all, v_all, lam)), to_blocks(q, Q_BLOCK)))
    out_c = post(diff_attend(qc, kc, vc, lam)) if with_ctx else None
    return out, out_c


def mixer_window_gqa(q, k, v, qc, kc, vc, sink, cos, sin, with_ctx):
    b, s = q.shape[:2]
    span = Q_BLOCK + 2 * WINDOW
    q = apply_rope(q, cos, sin)
    k = apply_rope(k, cos, sin)
    pad = ((0, 0), (WINDOW, WINDOW), (0, 0), (0, 0))
    k_pad = jnp.pad(k, pad)
    v_pad = jnp.pad(v, pad)
    ctx_bias = jnp.zeros((Q_BLOCK, kc.shape[1]), jnp.float32)

    def block(args):
        i, qb = args
        start = i * Q_BLOCK
        kb = lax.dynamic_slice_in_dim(k_pad, start, span, axis=1)
        vb = lax.dynamic_slice_in_dim(v_pad, start, span, axis=1)
        q_pos = start + jnp.arange(Q_BLOCK)
        k_pos = start - WINDOW + jnp.arange(span)
        valid = (k_pos[None, :] >= 0) & (k_pos[None, :] < s) & (jnp.abs(q_pos[:, None] - k_pos[None, :]) <= WINDOW)
        bias = jnp.concatenate([jnp.where(valid, 0.0, NEG_INF), ctx_bias], axis=-1)
        return gqa_attend(qb, jnp.concatenate([kb, kc], axis=1), jnp.concatenate([vb, vc], axis=1), bias=bias, sink=sink)

    out = from_blocks(lax.map(block, (jnp.arange(s // Q_BLOCK), to_blocks(q, Q_BLOCK))))
    out_c = gqa_attend(qc, kc, vc, sink=sink) if with_ctx else None
    return out, out_c


def squared_relu_mlp(h, w_up, w_down):
    return jnp.square(jax.nn.relu(h @ w_up)) @ w_down


def setup_inputs(seed: int = 0) -> dict:
    key = jax.random.key(seed)
    ks = iter(jax.random.split(key, 24))

    def nrm(shape, scale=1.0):
        return jax.random.normal(next(ks), shape, jnp.float32) * scale

    def gain(shape):
        return 1.0 + 0.1 * nrm(shape)

    L = DEPTH
    return {
        'x': nrm((BATCH, SEQ, D_MODEL)),
        'c': nrm((BATCH, D_MODEL)),
        'ctx': nrm((BATCH, CTX_LEN, D_MODEL)),
        'c_ctx': nrm((D_MODEL,)),
        'g_mix': gain((L, D_MODEL)),
        'g_mlp': gain((L, D_MODEL)),
        'w_mod': nrm((L, D_MODEL, N_MOD * D_MODEL), 0.5 * D_MODEL ** -0.5),
        'b_mod': nrm((L, N_MOD * D_MODEL), 0.02),
        'w_in': nrm((L, D_MODEL, PROJ_WIDTH), D_MODEL ** -0.5),
        'w_out': nrm((L, MIX_WIDTH, D_MODEL), MIX_WIDTH ** -0.5),
        'gqa_gq': gain((L, HEAD_DIM)),
        'gqa_gk': gain((L, HEAD_DIM)),
        'na_rpb': nrm((L, NA_HEADS, 2 * WIN_ROWS - 1, 2 * WIN_COLS - 1), 0.1),
        'diff_lq1': nrm((L, DIFF_QK_DIM), 0.1),
        'diff_lk1': nrm((L, DIFF_QK_DIM), 0.1),
        'diff_lq2': nrm((L, DIFF_QK_DIM), 0.1),
        'diff_lk2': nrm((L, DIFF_QK_DIM), 0.1),
        'diff_gsub': gain((L, HEAD_DIM)),
        'swa_sink': nrm((L, SWA_HEADS), 0.5),
        'w_up': nrm((L, D_MODEL, MLP_HIDDEN), D_MODEL ** -0.5),
        'w_down': nrm((L, MLP_HIDDEN, D_MODEL), MLP_HIDDEN ** -0.5),
        'g_final': gain((D_MODEL,)),
    }


def reference(x, c, ctx, c_ctx, g_mix, g_mlp, w_mod, b_mod, w_in, w_out, gqa_gq, gqa_gk, na_rpb,
              diff_lq1, diff_lk1, diff_lq2, diff_lk2, diff_gsub, swa_sink, w_up, w_down, g_final):
    b, s, _ = x.shape
    cos_h, sin_h = axial_rope(s, HEAD_DIM)
    cos_d, sin_d = axial_rope(s, DIFF_QK_DIM)
    cond_x = jax.nn.silu(c)
    cond_c = jax.nn.silu(c_ctx)
    for l in range(DEPTH):
        with_ctx = l < DEPTH - 1
        mod_x = (cond_x @ w_mod[l] + b_mod[l]).reshape(b, N_MOD, 1, D_MODEL)
        mod_c = (cond_c @ w_mod[l] + b_mod[l]).reshape(N_MOD, 1, D_MODEL)
        hx = modulate(rms_norm(x, g_mix[l]), mod_x[:, 0], mod_x[:, 1])
        hc = modulate(rms_norm(ctx, g_mix[l]), mod_c[0], mod_c[1])
        (aq, ak, av, bq, bk, bv, cq, ck, cv, dq, dk, dv) = split_heads(hx @ w_in[l])
        (aqc, akc, avc, bqc, bkc, bvc, cqc, ckc, cvc, dqc, dkc, dvc) = split_heads(hc @ w_in[l])
        oa, oa_c = mixer_global_gqa(aq, ak, av, aqc, akc, avc, gqa_gq[l], gqa_gk[l], cos_h, sin_h, with_ctx)
        ob, ob_c = mixer_neighbourhood(bq, bk, bv, bqc, bkc, bvc, na_rpb[l], with_ctx)
        oc, oc_c = mixer_diff(cq, ck, cv, cqc, ckc, cvc, diff_lq1[l], diff_lk1[l], diff_lq2[l], diff_lk2[l],
                              diff_gsub[l], 0.8 - 0.6 * math.exp(-0.3 * l), cos_d, sin_d, with_ctx)
        od, od_c = mixer_window_gqa(dq, dk, dv, dqc, dkc, dvc, swa_sink[l], cos_h, sin_h, with_ctx)
        x = x + mod_x[:, 2] * (jnp.concatenate([oa, ob, oc, od], axis=-1) @ w_out[l])
        x = x + mod_x[:, 5] * squared_relu_mlp(modulate(rms_norm(x, g_mlp[l]), mod_x[:, 3], mod_x[:, 4]), w_up[l], w_down[l])
        if with_ctx:
            ctx = ctx + mod_c[2] * (jnp.concatenate([oa_c, ob_c, oc_c, od_c], axis=-1) @ w_out[l])
            ctx = ctx + mod_c[5] * squared_relu_mlp(modulate(rms_norm(ctx, g_mlp[l]), mod_c[3], mod_c[4]), w_up[l], w_down[l])
    return rms_norm(x, g_final)
```

```cpp
#include <hip/hip_runtime.h>
#include <hip/hip_cooperative_groups.h>
#include <cstdio>
#include <cstdint>
namespace cg = cooperative_groups;

constexpr int DM = 2048, NB = 8, SEQ = 2048, CTXL = 256, PW = 5120, HID = 8192, HIDP = HID + 64  , NMOD = 6, MODW = NMOD * DM;
constexpr int MX = NB * SEQ, MC = NB * CTXL, MT = MX + MC;
constexpr float NORM_EPS = 1e-6f;
constexpr int NWAVES = 8, NTHREADS = 512;
constexpr int LDS_BYTES = 147456;
constexpr size_t WIN_B = (size_t)PW * DM * 2, WOUT_B = (size_t)DM * DM * 2, WUP_B = (size_t)HID * DM * 2, WDN_B = (size_t)DM * HIDP * 2, WL_B = WIN_B + WOUT_B + WUP_B + WDN_B;
constexpr size_t WS_WT = 1u << 20;
constexpr size_t WS_MOD = WS_WT + 2 * WL_B;
constexpr size_t MOD_B = (size_t)2 * 9 * MODW * 4;
constexpr size_t WS_ROPE = WS_MOD + MOD_B;
constexpr size_t ROPE_B = (size_t)2048 * 64 * 4 * 2 + (size_t)2048 * 32 * 4 * 2;
constexpr size_t WS_X = WS_ROPE + ROPE_B;
constexpr size_t X_B = (size_t)MT * DM * 4;
constexpr size_t WS_H0 = WS_X + X_B;
constexpr size_t H0_B = (size_t)MT * DM * 2;
constexpr size_t WS_BIG = WS_H0 + H0_B;
constexpr size_t BIG_B = (size_t)MT * HIDP * 2;
constexpr size_t WS_P = WS_BIG, P_B = (size_t)MT * PW * 2;
constexpr size_t WS_AO = WS_P + P_B, AO_B = (size_t)MT * DM * 2;
static_assert(WS_AO + AO_B <= WS_BIG + BIG_B, "overlay");
constexpr size_t WS_STASH = WS_BIG + BIG_B, STASH_B = (size_t)256 * 2 * 256 * 128 * 4;
constexpr size_t WS_END = WS_STASH + STASH_B;
static_assert(WS_MOD % 256 == 0 && WS_ROPE % 256 == 0 && WS_X % 256 == 0 && WS_H0 % 256 == 0 && WS_BIG % 256 == 0 && WS_AO % 256 == 0 && WS_STASH % 256 == 0, "align");

typedef unsigned short bf16;
#define LAS __attribute__((address_space(3)))
__device__ __forceinline__ float bf2f(unsigned v) { return __builtin_bit_cast(float, v << 16); }
__device__ __forceinline__ unsigned f2bf(float f) { unsigned u = __builtin_bit_cast(unsigned, f); return (u + 0x7fffu + ((u >> 16) & 1u)) >> 16; }
__device__ __forceinline__ unsigned pk2(float lo, float hi) { return f2bf(lo) | (f2bf(hi) << 16); }
template <int K> __device__ __forceinline__ float sum_xor(float v) {
    if constexpr (K < 32) return v + __builtin_bit_cast(float, __builtin_amdgcn_ds_swizzle(__builtin_bit_cast(int, v), (K << 10) | 0x1f));
    else { const unsigned b = __builtin_bit_cast(unsigned, v); auto rr = __builtin_amdgcn_permlane32_swap(b, b, false, false); return __builtin_bit_cast(float, (unsigned)rr[0]) + __builtin_bit_cast(float, (unsigned)rr[1]); }
}
__device__ __forceinline__ float wave_sum(float v) {
    v = sum_xor<1>(v); v = sum_xor<2>(v); v = sum_xor<4>(v); v = sum_xor<8>(v); v = sum_xor<16>(v); v = sum_xor<32>(v);
    return v;
}
#define MK_COOP 1
#define RES_SP2 false
#define XB_TMO      128
#define XB_XCNT(j)  (256  + 64 * (j))
#define XB_XSUB(j)  (1280 + 64 * (j))
#define XB_XGEN(j)  (2304 + 64 * (j))
#define XB_TOP      3328
#define XB_TOPGEN   3392
#define XCD_BAR_WORDS 3456
#define XB_SPIN_CAP (1u << 18)

__device__ __forceinline__ unsigned xb_ld(unsigned* p)              { return __hip_atomic_load(p, __ATOMIC_RELAXED, __HIP_MEMORY_SCOPE_AGENT); }
__device__ __forceinline__ unsigned xb_add(unsigned* p, unsigned v) { return __hip_atomic_fetch_add(p, v, __ATOMIC_RELAXED, __HIP_MEMORY_SCOPE_AGENT); }
__device__ __forceinline__ unsigned xb_xcc_id() { return (unsigned)__builtin_amdgcn_s_getreg((3 << 11) | 20) & 0xFu; }
#define XB_SPIN(cond, bar) do { unsigned _sp = 0; while (cond) { __builtin_amdgcn_s_sleep(1); \
    if ((++_sp & 255u) == 0u) { if (xb_ld(&(bar)[XB_TMO])) break; if (_sp > XB_SPIN_CAP) { atomicAdd(&(bar)[XB_TMO], 1u); break; } } } } while (0)

struct XcdBarrier {
    unsigned* bar; unsigned x;
    volatile LAS unsigned* st;
};

__device__ __forceinline__ XcdBarrier xcd_barrier_post(unsigned* bar, volatile LAS unsigned* st) {
    XcdBarrier b; b.bar = bar; b.x = xb_xcc_id(); b.st = st;
    if (threadIdx.x == 0) (void)xb_add(&bar[XB_XCNT(b.x)], 1u);
    return b;
}
__device__ __forceinline__ void xcd_barrier_complete(unsigned* bar, unsigned x, unsigned& nloc, unsigned& nx) {
    const unsigned G = gridDim.x * gridDim.y * gridDim.z;
    unsigned sum, cnt, mine, sp = 0u;
    for (;;) {
        sum = 0u; cnt = 0u; mine = 0u;
#pragma unroll
        for (unsigned j = 0; j < 16; ++j) { const unsigned c = xb_ld(&bar[XB_XCNT(j)]); sum += c; cnt += (c > 0u) ? 1u : 0u; mine = (j == x) ? c : mine; }
        if (sum == G) break;
        __builtin_amdgcn_s_sleep(1);
        if ((++sp & 255u) == 0u) { if (xb_ld(&bar[XB_TMO])) break; if (sp > XB_SPIN_CAP) { atomicAdd(&bar[XB_TMO], 1u); break; } }
    }
    nloc = mine > 0u ? mine : 1u; nx = cnt > 0u ? cnt : 1u;
}

__device__ __forceinline__ void xcd_barrier(const XcdBarrier& b) {
    asm volatile("s_waitcnt vmcnt(0)" ::: "memory");
    __syncthreads();
    if (threadIdx.x == 0) {
        unsigned* bar = b.bar;
        __builtin_amdgcn_s_waitcnt(0);
        unsigned nloc = b.st[0], nx = b.st[1];
        if (nloc == 0u) { xcd_barrier_complete(bar, b.x, nloc, nx); b.st[0] = nloc; b.st[1] = nx; }
        const unsigned old = xb_add(&bar[XB_XSUB(b.x)], 1u);
        const unsigned gen = old / nloc;
        if (old + 1u == (gen + 1u) * nloc) {
            __builtin_amdgcn_fence(__ATOMIC_RELEASE, "agent");
            asm volatile("s_waitcnt vmcnt(0)" ::: "memory");
            const unsigned og = xb_add(&bar[XB_TOP], 1u);
            const unsigned tg = og / nx;
            if (og + 1u == (tg + 1u) * nx) xb_add(&bar[XB_TOPGEN], 1u);
            else XB_SPIN(xb_ld(&bar[XB_TOPGEN]) == tg, bar);
            __builtin_amdgcn_fence(__ATOMIC_ACQUIRE, "agent");
            xb_add(&bar[XB_XGEN(b.x)], 1u);
            asm volatile("s_waitcnt vmcnt(0)" ::: "memory");
        } else {
            XB_SPIN(xb_ld(&bar[XB_XGEN(b.x)]) == gen, bar);
            __builtin_amdgcn_fence(__ATOMIC_ACQUIRE, "agent");
            asm volatile("s_waitcnt vmcnt(0)" ::: "memory");
        }
    }
    __syncthreads();
}
namespace pg8 {
#define PG8_LAS __attribute__((address_space(3)))
typedef unsigned short bf16_t;
typedef short bf16x8 __attribute__((ext_vector_type(8)));
typedef float f32x4 __attribute__((ext_vector_type(4)));
typedef unsigned u32x4 __attribute__((ext_vector_type(4)));
constexpr int BM = 256, BK = 64, HALF = 128, HTB = HALF * BK * 2  , STAGE_BYTES = 8 * HTB, NXCD = 8, WGM = 8;

__host__ __device__ __forceinline__ int lds_byte(int r, int c) { const int st = (r >> 4) * 2 + (c >> 5), rr = r & 15, cc = c & 31, ob = rr * 64 + cc * 2; return st * 1024 + (ob ^ (((ob >> 9) & 1) << 5)); }
__host__ __device__ __forceinline__ void stage_rc(int b, int& R, int& C) { const int st = b / 1024, sb = b % 1024, swz = sb ^ (((sb >> 9) & 1) << 5); R = (st >> 1) * 16 + swz / 64; C = (st & 1) * 32 + (swz % 64) / 2; }
__host__ __device__ __forceinline__ int perm32(int rho) { const int n = rho >> 4, i = rho & 15; return 8 * (i >> 2) + 4 * n + (i & 3); }

struct Unit { int pm, pn, ks; };
struct Gemm { const bf16_t* A; const bf16_t* Bt; int M, N, K, Kext; };

struct StaticOrder {
    int nM, nN, nwg, G, c, wgm;
    __host__ __device__ void init(int M, int N, int G_, int c_, int wgm_ = WGM) { nM = M / BM; nN = N / BM; nwg = nM * nN; G = G_; c = c_; wgm = wgm_; }
    __host__ __device__ bool next(int i, Unit& u) const {
        const long L = (long)i * G + c; if (L >= nwg) return false;
        int wgid = (int)L; { const int q = nwg / NXCD, r = nwg % NXCD, xcd = wgid % NXCD, off = wgid / NXCD; wgid = (xcd < r ? xcd * (q + 1) : r * (q + 1) + (xcd - r) * q) + off; }
        const int nig = wgm * nN, gid = wgid / nig, fm = gid * wgm, gsz = (nM - fm) < wgm ? (nM - fm) : wgm;
        u.pm = fm + ((wgid % nig) % gsz); u.pn = (wgid % nig) / gsz; u.ks = 0; return true;
    }
    __device__ __forceinline__ void a_ready(const Unit&) const {}
    __device__ __forceinline__ void done(const Unit&) const {}
};

__device__ __forceinline__ unsigned cvt_pk_bf16(float lo, float hi) { unsigned r; asm volatile("v_cvt_pk_bf16_f32 %0, %1, %2" : "=v"(r) : "v"(lo), "v"(hi)); return r; }
typedef float f32x2 __attribute__((ext_vector_type(2)));
template <int ACT> struct EpiStore {
    static constexpr bool PERM = true, AFTER_DRAIN = false;
    bf16_t* O; int ldc;
    __device__ __forceinline__ void operator()(const f32x4 (&acc)[2][2][4][2], const Unit& u, int wr, int wc, int fr, int fq) const {
        const int row0 = u.pm * BM + wr * 64 + fr; const int col0 = u.pn * BM + wc * 32 + 8 * fq;
#pragma unroll
        for (int ai = 0; ai < 2; ++ai)
#pragma unroll
            for (int m = 0; m < 4; ++m) { bf16_t* rowp = O + (size_t)(row0 + ai * HALF + m * 16) * ldc + col0;
#pragma unroll
                for (int bj = 0; bj < 2; ++bj) { f32x4 v0 = acc[ai][bj][m][0], v1 = acc[ai][bj][m][1];
                    if (ACT == 1) {
#pragma unroll
                        for (int e = 0; e < 4; ++e) { float a = fmaxf(v0[e], 0.f), b = fmaxf(v1[e], 0.f); v0[e] = a * a; v1[e] = b * b; } }
                    u32x4 w; w.x = cvt_pk_bf16(v0[0], v0[1]); w.y = cvt_pk_bf16(v0[2], v0[3]); w.z = cvt_pk_bf16(v1[0], v1[1]); w.w = cvt_pk_bf16(v1[2], v1[3]);
                    *(u32x4*)(rowp + bj * HALF) = w; } }
    }
};
struct EpiResid {
    static constexpr bool PERM = false, AFTER_DRAIN = false;
    const float* resX; const float* resC; float* out; const float* gate; bf16_t* xb;
    __device__ __forceinline__ void operator()(const f32x4 (&acc)[2][2][4][2], const Unit& u, int wr, int wc, int fr, int fq) const {
        const int batch = u.pm < 64 ? (u.pm >> 3) : 8;
        const float* res = u.pm < 64 ? resX + (size_t)u.pm * BM * 2048 : resC + (size_t)(u.pm - 64) * BM * 2048;
        float* o = out + (size_t)u.pm * BM * 2048;
        const int col0 = u.pn * BM + wc * 32 + 4 * fq;
        const float* gp = gate + (size_t)batch * 12288 + col0;
        f32x4 gv[2][2];
#pragma unroll
        for (int bj = 0; bj < 2; ++bj)
#pragma unroll
            for (int n = 0; n < 2; ++n) gv[bj][n] = *(const f32x4*)(gp + bj * HALF + n * 16);
#pragma unroll
        for (int ai = 0; ai < 2; ++ai)
#pragma unroll
          for (int mh = 0; mh < 2; ++mh) {
            f32x4 rv[2][2][2];
#pragma unroll
            for (int mm = 0; mm < 2; ++mm) { const int m = mh * 2 + mm; const size_t off = (size_t)(ai * HALF + wr * 64 + m * 16 + fr) * 2048 + col0;
#pragma unroll
                for (int bj = 0; bj < 2; ++bj)
#pragma unroll
                    for (int n = 0; n < 2; ++n) rv[mm][bj][n] = *(const f32x4*)(res + off + bj * HALF + n * 16); }
            __builtin_amdgcn_sched_barrier(0);
#pragma unroll
            for (int mm = 0; mm < 2; ++mm) { const int m = mh * 2 + mm; const size_t off = (size_t)(ai * HALF + wr * 64 + m * 16 + fr) * 2048 + col0;
#pragma unroll
                for (int bj = 0; bj < 2; ++bj)
#pragma unroll
                    for (int n = 0; n < 2; ++n) { const f32x4 y = rv[mm][bj][n] + gv[bj][n] * acc[ai][bj][m][n]; *(f32x4*)(o + off + bj * HALF + n * 16) = y;
                        if (xb) { typedef unsigned u32x2 __attribute__((ext_vector_type(2))); u32x2 w; w.x = cvt_pk_bf16(y[0], y[1]); w.y = cvt_pk_bf16(y[2], y[3]); *(u32x2*)(xb + (size_t)u.pm * BM * 2048 + off + bj * HALF + n * 16) = w; } } }
            __builtin_amdgcn_sched_barrier(0);
          }
    }
};

struct EpiPart {
    static constexpr bool PERM = false, AFTER_DRAIN = false;
    float* part; int pm0; size_t slice;
    __device__ __forceinline__ void operator()(const f32x4 (&acc)[2][2][4][2], const Unit& u, int wr, int wc, int fr, int fq) const {
        float* o = part + (size_t)u.ks * slice + (size_t)(u.pm - pm0) * BM * 2048;
        const int col0 = u.pn * BM + wc * 32 + 4 * fq;
#pragma unroll
        for (int ai = 0; ai < 2; ++ai)
#pragma unroll
            for (int m = 0; m < 4; ++m) { const size_t off = (size_t)(ai * HALF + wr * 64 + m * 16 + fr) * 2048 + col0;
#pragma unroll
                for (int bj = 0; bj < 2; ++bj)
#pragma unroll
                    for (int n = 0; n < 2; ++n) *(f32x4*)(o + off + bj * HALF + n * 16) = acc[ai][bj][m][n]; }
    }
};
struct SplitOrder {
    int pm0, nM, nN, NS, G, c;
    __host__ __device__ void init(int pm0_, int nM_, int nN_, int NS_, int G_, int c_) { pm0 = pm0_; nM = nM_; nN = nN_; NS = NS_; G = G_; c = c_; }
    __host__ __device__ bool next(int i, Unit& u) const {
        const long L = (long)i * G + c; if (L >= (long)nM * nN * NS) return false;
        const int t = (int)L / NS; u.ks = (int)L % NS; u.pm = pm0 + t % nM; u.pn = t / nM; return true;
    }
    __device__ __forceinline__ void a_ready(const Unit&) const {}
    __device__ __forceinline__ void done(const Unit&) const {}
};

struct EpiInProj {
    static constexpr bool PERM = true, AFTER_DRAIN = false;
    bf16_t* O; int ldc; const float* gq; const float* gk; const float* rope; PG8_LAS float* red;
    __device__ __forceinline__ void operator()(const f32x4 (&acc)[2][2][4][2], const Unit& u, int wr, int wc, int fr, int fq) const {
        const int pn = u.pn; const bool lat = u.pm < 64;
        const int kind = pn <= 2 ? 1 : ((pn >= 10 && pn <= 13) ? 2 : ((pn >= 16 && pn <= 18) ? 3 : 0));
        const int row0 = u.pm * BM + wr * 64 + fr; const int col0 = pn * BM + wc * 32 + 8 * fq;
        const bool do_rope = lat && kind != 0;
        f32x4 g0 = (f32x4){1.f, 1.f, 1.f, 1.f}, g1 = g0;
        if (kind == 1) {
            const float* gp = (pn < 2 ? gq : gk) + wc * 32 + 8 * fq; g0 = *(const f32x4*)gp; g1 = *(const f32x4*)(gp + 4);
#pragma unroll
            for (int ai = 0; ai < 2; ++ai)
#pragma unroll
                for (int m = 0; m < 4; ++m)
#pragma unroll
                    for (int bj = 0; bj < 2; ++bj) { const f32x4 a = acc[ai][bj][m][0], b = acc[ai][bj][m][1];
                        float s = (a[0] * a[0] + a[1] * a[1]) + (a[2] * a[2] + a[3] * a[3]) + (b[0] * b[0] + b[1] * b[1]) + (b[2] * b[2] + b[3] * b[3]);
                        s = ::sum_xor<16>(s); s = ::sum_xor<32>(s);
                        if (fq == 0) red[((ai * HALF + wr * 64 + m * 16 + fr) * 2 + bj) * 4 + wc] = s; }
            asm volatile("s_waitcnt lgkmcnt(0)" ::: "memory"); __builtin_amdgcn_s_barrier(); asm volatile("" ::: "memory");
        }
        const float* cosT = rope; const float* sinT = rope + 2048 * 64; int tw = 64, p0 = wc * 16 + 4 * fq;
        if (kind == 2) { cosT = rope + 2 * 2048 * 64; sinT = cosT + 2048 * 32; tw = 32; p0 = (wc & 1) * 16 + 4 * fq; }
        f32x4 csa[2][4], sna[2][4];
#pragma unroll
        for (int ai = 0; ai < 2; ++ai)
#pragma unroll
            for (int m = 0; m < 4; ++m) { csa[ai][m] = (f32x4){1.f, 1.f, 1.f, 1.f}; sna[ai][m] = (f32x4){0.f, 0.f, 0.f, 0.f};
                if (do_rope) { const int pos = (row0 + ai * HALF + m * 16) & 2047; csa[ai][m] = *(const f32x4*)(cosT + pos * tw + p0); sna[ai][m] = *(const f32x4*)(sinT + pos * tw + p0); } }
        __builtin_amdgcn_sched_barrier(0);
#pragma unroll
        for (int ai = 0; ai < 2; ++ai)
#pragma unroll
            for (int m = 0; m < 4; ++m) { const int row = row0 + ai * HALF + m * 16; bf16_t* rowp = O + ((size_t)(pn * 2) * ldc + row) * 128 + wc * 32 + 8 * fq;
                const f32x4 cs = csa[ai][m], sn = sna[ai][m];
#pragma unroll
                for (int bj = 0; bj < 2; ++bj) { f32x4 v0 = acc[ai][bj][m][0], v1 = acc[ai][bj][m][1];
                    if (kind == 1) { const f32x4 t = *(const PG8_LAS f32x4*)(red + ((ai * HALF + wr * 64 + m * 16 + fr) * 2 + bj) * 4);
                        const float r = 1.0f / sqrtf(((t[0] + t[1]) + (t[2] + t[3])) * (1.0f / 128.0f) + 1e-6f); v0 = v0 * r * g0; v1 = v1 * r * g1; }
                    if (kind != 0) { const f32x4 a = v0, b = v1;
                        v0[0] = a[0] * cs[0] - a[1] * sn[0]; v0[1] = a[0] * sn[0] + a[1] * cs[0]; v0[2] = a[2] * cs[1] - a[3] * sn[1]; v0[3] = a[2] * sn[1] + a[3] * cs[1];
                        v1[0] = b[0] * cs[2] - b[1] * sn[2]; v1[1] = b[0] * sn[2] + b[1] * cs[2]; v1[2] = b[2] * cs[3] - b[3] * sn[3]; v1[3] = b[2] * sn[3] + b[3] * cs[3]; }
                    u32x4 w; w.x = cvt_pk_bf16(v0[0], v0[1]); w.y = cvt_pk_bf16(v0[2], v0[3]); w.z = cvt_pk_bf16(v1[0], v1[1]); w.w = cvt_pk_bf16(v1[2], v1[3]);
                    *(u32x4*)(rowp + (size_t)bj * ldc * 128) = w; } }
    }
};
template <class Epi, class Sched, bool ALIGN_EPI = false, bool SP2 = false>
__device__ __forceinline__ void gemm_phase(PG8_LAS unsigned char* lds, const Gemm g, const Sched& S, const Epi& E) {
    int tid_ = threadIdx.x; asm volatile("" : "+v"(tid_));
    const int tid = tid_, wid = __builtin_amdgcn_readfirstlane(tid >> 6), lane = tid & 63, wr = wid >> 2, wc = wid & 3, fr = lane & 15, fq = lane >> 4;
    const int K = g.K, nt = g.Kext / BK; const size_t sstep = (size_t)g.Kext * 2;
    unsigned voffA[2], voffB[2];
#pragma unroll
    for (int i = 0; i < 2; ++i) { int R, C; stage_rc(tid * 16 + i * 8192, R, C); const int Rb = Epi::PERM ? ((R & ~31) + perm32(R & 31)) : R;
        voffA[i] = (unsigned)(R * K + C) * 2u; voffB[i] = (unsigned)(Rb * K + C) * 2u; }
    const size_t kstep = (size_t)(BK * 2);
    const size_t hstep = (size_t)HALF * K * 2;
    const size_t tstep = 2 * hstep;
    const unsigned ldsw = (unsigned)wid * 1024u;
    const int aoff = lds_byte(wr * 64 + fr, fq * 8), boff = lds_byte(wc * 32 + fr, fq * 8);
#define PG8_SA(b, h) (((b) * 2 + (h)) * HTB)
#define PG8_SB(b, h) ((4 + (b) * 2 + (h)) * HTB)
#define PG8_STAGE(bufoff, gbase, voff) do { _Pragma("unroll") for (int _i = 0; _i < 2; ++_i) \
        __builtin_amdgcn_global_load_lds((const unsigned*)((const char*)(gbase) + (voff)[_i]), (PG8_LAS unsigned*)(lds + (bufoff) + ldsw + _i * 8192), 16, 0, 0); } while (0)
#define PG8_LDA(dst, b, h) do { _Pragma("unroll") for (int m = 0; m < 4; ++m) _Pragma("unroll") for (int k = 0; k < 2; ++k) dst[m][k] = *(const PG8_LAS bf16x8*)(lds + PG8_SA(b, h) + aoff + m * 2048 + k * 1024); } while (0)
#define PG8_LDB(dst, b, h) do { _Pragma("unroll") for (int n = 0; n < 2; ++n) _Pragma("unroll") for (int k = 0; k < 2; ++k) dst[n][k] = *(const PG8_LAS bf16x8*)(lds + PG8_SB(b, h) + boff + n * 2048 + k * 1024); } while (0)
#define PG8_MMA(ai, bj, At, Bt) do { __builtin_amdgcn_s_setprio(1); _Pragma("unroll") for (int m = 0; m < 4; ++m) _Pragma("unroll") for (int n = 0; n < 2; ++n) _Pragma("unroll") for (int k = 0; k < 2; ++k) \
        acc[ai][bj][m][n] = __builtin_amdgcn_mfma_f32_16x16x32_bf16(Bt[n][k], At[m][k], acc[ai][bj][m][n], 0, 0, 0); __builtin_amdgcn_s_setprio(0); } while (0)
#define PG8_WAIT_V(n) asm volatile("s_waitcnt vmcnt(" #n ")" ::: "memory")
#define PG8_WAIT_L(n) asm volatile("s_waitcnt lgkmcnt(" #n ")" ::: "memory")
#define PG8_BAR __builtin_amdgcn_s_barrier()
#define PG8_SCHED __builtin_amdgcn_sched_barrier(0)
    Unit cur, nxt; int ui = 0;
    if (!S.next(0, cur)) return;
    f32x4 acc[2][2][4][2];
#pragma unroll
    for (int a = 0; a < 2; ++a)
#pragma unroll
        for (int b = 0; b < 2; ++b)
#pragma unroll
            for (int m = 0; m < 4; ++m)
#pragma unroll
                for (int n = 0; n < 2; ++n) acc[a][b][m][n] = (f32x4){0.f, 0.f, 0.f, 0.f};
    bf16x8 At[4][2], B0[2][2], B1[2][2];
    const char* cA = (const char*)g.A + (size_t)cur.pm * tstep + (size_t)cur.ks * sstep; const char* cB = (const char*)g.Bt + (size_t)cur.pn * tstep + (size_t)cur.ks * sstep;
    S.a_ready(cur);
    if constexpr (SP2) {
        PG8_STAGE(PG8_SB(0, 0), cB, voffB); PG8_STAGE(PG8_SB(0, 1), cB + hstep, voffB); PG8_STAGE(PG8_SA(0, 0), cA, voffA); PG8_STAGE(PG8_SA(0, 1), cA + hstep, voffA);
        if (wr == 1) PG8_BAR;
        PG8_WAIT_V(2); PG8_BAR;
        PG8_STAGE(PG8_SB(1, 0), cB + kstep, voffB); PG8_STAGE(PG8_SA(1, 0), cA + kstep, voffA); PG8_STAGE(PG8_SB(1, 1), cB + hstep + kstep, voffB);
        PG8_WAIT_V(6); PG8_BAR;
    } else {
        PG8_STAGE(PG8_SB(0, 0), cB, voffB); PG8_STAGE(PG8_SA(0, 0), cA, voffA); PG8_STAGE(PG8_SB(0, 1), cB + hstep, voffB); PG8_STAGE(PG8_SA(0, 1), cA + hstep, voffA);
        if (wr == 1) PG8_BAR;
        PG8_WAIT_V(4); PG8_BAR;
        PG8_STAGE(PG8_SB(1, 0), cB + kstep, voffB); PG8_STAGE(PG8_SA(1, 0), cA + kstep, voffA); PG8_STAGE(PG8_SB(1, 1), cB + hstep + kstep, voffB);
        PG8_WAIT_V(6); PG8_BAR;
    }
    for (;;) {
        const bool has_next = S.next(ui + 1, nxt);
        const char* nA = has_next ? (const char*)g.A + (size_t)nxt.pm * tstep + (size_t)nxt.ks * sstep : cA; const char* nB = has_next ? (const char*)g.Bt + (size_t)nxt.pn * tstep + (size_t)nxt.ks * sstep : cB;
        for (int t = 0; t < nt; t += 2) {
            const bool last = (t == nt - 2);
            const char* a1 = cA + (size_t)(t + 1) * kstep;
            const char* a2 = last ? nA : cA + (size_t)(t + 2) * kstep; const char* b2 = last ? nB : cB + (size_t)(t + 2) * kstep;
            const char* a3 = a2 + kstep; const char* b3 = b2 + kstep;
            if (last && has_next) S.a_ready(nxt);
            if constexpr (SP2) {
            PG8_LDB(B0, 0, 0); PG8_LDB(B1, 0, 1); PG8_SCHED; PG8_LDA(At, 0, 0); PG8_STAGE(PG8_SA(1, 1), a1 + hstep, voffA);
            PG8_WAIT_V(8); PG8_WAIT_L(0); PG8_BAR; PG8_MMA(0, 0, At, B0); PG8_MMA(0, 1, At, B1); PG8_BAR; PG8_SCHED;
            PG8_LDA(At, 0, 1); PG8_STAGE(PG8_SB(0, 0), b2, voffB); PG8_STAGE(PG8_SB(0, 1), b2 + hstep, voffB); PG8_STAGE(PG8_SA(0, 0), a2, voffA);
            PG8_WAIT_V(8); PG8_WAIT_L(0); PG8_BAR; PG8_MMA(1, 0, At, B0); PG8_MMA(1, 1, At, B1); PG8_BAR; PG8_SCHED;
            PG8_LDB(B0, 1, 0); PG8_LDB(B1, 1, 1); PG8_SCHED; PG8_LDA(At, 1, 0); PG8_STAGE(PG8_SA(0, 1), a2 + hstep, voffA);
            PG8_WAIT_V(8); PG8_WAIT_L(0); PG8_BAR; PG8_MMA(0, 0, At, B0); PG8_MMA(0, 1, At, B1); PG8_BAR; PG8_SCHED;
            PG8_LDA(At, 1, 1); PG8_STAGE(PG8_SB(1, 0), b3, voffB); PG8_STAGE(PG8_SB(1, 1), b3 + hstep, voffB); PG8_STAGE(PG8_SA(1, 0), a3, voffA);
            PG8_WAIT_V(8); PG8_WAIT_L(0); PG8_BAR; PG8_MMA(1, 0, At, B0); PG8_MMA(1, 1, At, B1); PG8_BAR; PG8_SCHED;
            } else {
            PG8_LDB(B0, 0, 0); PG8_SCHED; PG8_LDA(At, 0, 0); PG8_STAGE(PG8_SA(1, 1), a1 + hstep, voffA);
            PG8_WAIT_L(8); PG8_BAR; PG8_WAIT_L(0); PG8_MMA(0, 0, At, B0); PG8_BAR; PG8_SCHED;
            PG8_LDB(B1, 0, 1); PG8_STAGE(PG8_SB(0, 0), b2, voffB);
            PG8_BAR; PG8_WAIT_L(0); PG8_MMA(0, 1, At, B1); PG8_BAR;
            PG8_LDA(At, 0, 1); PG8_STAGE(PG8_SA(0, 0), a2, voffA);
            PG8_BAR; PG8_WAIT_L(0); PG8_MMA(1, 0, At, B0); PG8_BAR; PG8_SCHED;
            PG8_STAGE(PG8_SB(0, 1), b2 + hstep, voffB);
            PG8_WAIT_V(6); PG8_BAR; PG8_MMA(1, 1, At, B1); PG8_BAR;
            PG8_LDB(B0, 1, 0); PG8_SCHED; PG8_LDA(At, 1, 0); PG8_STAGE(PG8_SA(0, 1), a2 + hstep, voffA);
            PG8_WAIT_L(8); PG8_BAR; PG8_WAIT_L(0); PG8_MMA(0, 0, At, B0); PG8_BAR; PG8_SCHED;
            PG8_LDB(B1, 1, 1); PG8_STAGE(PG8_SB(1, 0), b3, voffB);
            PG8_BAR; PG8_WAIT_L(0); PG8_MMA(0, 1, At, B1); PG8_BAR;
            PG8_LDA(At, 1, 1); PG8_STAGE(PG8_SA(1, 0), a3, voffA);
            PG8_BAR; PG8_WAIT_L(0); PG8_MMA(1, 0, At, B0); PG8_BAR; PG8_SCHED;
            PG8_STAGE(PG8_SB(1, 1), b3 + hstep, voffB);
            PG8_WAIT_V(6); PG8_BAR; PG8_MMA(1, 1, At, B1); PG8_BAR;
            }
        }
        if constexpr (ALIGN_EPI) { if (wr == 0) PG8_BAR; }
        if constexpr (!Epi::AFTER_DRAIN) { E(acc, cur, wr, wc, fr, fq); S.done(cur); }
        if (!has_next) break;
#pragma unroll
        for (int a = 0; a < 2; ++a)
#pragma unroll
            for (int b = 0; b < 2; ++b)
#pragma unroll
                for (int m = 0; m < 4; ++m)
#pragma unroll
                    for (int n = 0; n < 2; ++n) acc[a][b][m][n] = (f32x4){0.f, 0.f, 0.f, 0.f};
        cur = nxt; cA = nA; cB = nB; ++ui;
        if constexpr (ALIGN_EPI) { if (wr == 1) PG8_BAR; }
    }
    PG8_WAIT_V(0);
    if constexpr (!ALIGN_EPI) { if (wr == 0) PG8_BAR; }
    PG8_BAR;
    if constexpr (Epi::AFTER_DRAIN) { E.fused(acc, cur, wr, wc, fr, fq, lds, wid, lane); S.done(cur); }
#undef PG8_SA
#undef PG8_SB
#undef PG8_STAGE
#undef PG8_LDA
#undef PG8_LDB
#undef PG8_MMA
#undef PG8_WAIT_V
#undef PG8_WAIT_L
#undef PG8_BAR
#undef PG8_SCHED
}
}
namespace att {
constexpr int NW_ = 8, QBLK = 32;
using bf16x8 = __attribute__((ext_vector_type(8))) short;
using s16x4  = __attribute__((ext_vector_type(4))) short;
using f32x16 = __attribute__((ext_vector_type(16))) float;
using f32x8  = __attribute__((ext_vector_type(8))) float;
using u32x4  = __attribute__((ext_vector_type(4))) unsigned;
#define KSWZ(row, colB) ((row) * 256 + ((colB) ^ (((row) & 7) << 4)))
#define SBAR() __builtin_amdgcn_sched_barrier(0)
__device__ __forceinline__ int crow(int r, int hi) { return (r & 3) + 8 * (r >> 2) + 4 * hi; }
__device__ __forceinline__ unsigned cvtpk(float lo, float hi) {
  unsigned r; asm volatile("v_cvt_pk_bf16_f32 %0, %1, %2" : "=v"(r) : "v"(lo), "v"(hi)); return r;
}
template <typename TIn> struct Stage;
template <> struct Stage<bf16>  { using T = bf16x8;
  __device__ static __forceinline__ T ld8(const bf16* p) { return *reinterpret_cast<const bf16x8*>(p); }
  __device__ static __forceinline__ bf16x8 tobf(T x) { return x; } };
template <> struct Stage<float> { using T = f32x8;
  __device__ static __forceinline__ T ld8(const float* p) { return *reinterpret_cast<const f32x8*>(p); }
  __device__ static __forceinline__ bf16x8 tobf(T x) {
    u32x4 w = {cvtpk(x[0], x[1]), cvtpk(x[2], x[3]), cvtpk(x[4], x[5]), cvtpk(x[6], x[7])}; return *reinterpret_cast<bf16x8*>(&w); } };

__device__ __forceinline__ void partialSM(f32x16& p0, f32x16& p1, float& m_reg, float& mn, float& alpha, const float C, const float thr_raw) {
  float pmax = p0[0]; for (int r = 1; r < 16; ++r) pmax = fmaxf(pmax, p0[r]); for (int r = 0; r < 16; ++r) pmax = fmaxf(pmax, p1[r]);
  { auto rr = __builtin_amdgcn_permlane32_swap(__float_as_uint(pmax), __float_as_uint(pmax), false, false);
    pmax = fmaxf(__uint_as_float(rr[0]), __uint_as_float(rr[1])); }
  if (__builtin_expect(__all(pmax - m_reg <= thr_raw), 1)) { mn = m_reg; alpha = 1.f; }
  else { mn = fmaxf(m_reg, pmax); alpha = __builtin_amdgcn_exp2f((m_reg - mn) * C); m_reg = mn; }
  float mnC = -mn * C;
  for (int r = 0; r < 16; ++r) p0[r] = fmaf(p0[r], C, mnC); for (int r = 0; r < 16; ++r) p1[r] = fmaf(p1[r], C, mnC);
  for (int r = 0; r < 16; ++r) p0[r] = __builtin_amdgcn_exp2f(p0[r]);
}
__device__ __forceinline__ void finishSM(f32x16& p0, f32x16& p1, float alpha, float& l_reg, bf16x8& pa0, bf16x8& pa1, bf16x8& pa2, bf16x8& pa3) {
  for (int r = 0; r < 16; ++r) p1[r] = __builtin_amdgcn_exp2f(p1[r]);
  float ps = 0; for (int r = 0; r < 16; ++r) ps += p0[r]; for (int r = 0; r < 16; ++r) ps += p1[r];
  { auto rr = __builtin_amdgcn_permlane32_swap(__float_as_uint(ps), __float_as_uint(ps), false, false);
    ps = __uint_as_float(rr[0]) + __uint_as_float(rr[1]); }
  l_reg = l_reg * alpha + ps;
#define PK4(P, BASE, OUT) do { unsigned a0 = cvtpk(P[BASE + 0], P[BASE + 1]), a1 = cvtpk(P[BASE + 2], P[BASE + 3]);   \
    unsigned b0 = cvtpk(P[BASE + 4], P[BASE + 5]), b1 = cvtpk(P[BASE + 6], P[BASE + 7]);                              \
    auto r0 = __builtin_amdgcn_permlane32_swap(a0, b0, false, false); auto r1 = __builtin_amdgcn_permlane32_swap(a1, b1, false, false); \
    u32x4 w = {r0[0], r1[0], r0[1], r1[1]}; OUT = *reinterpret_cast<bf16x8*>(&w); } while (0)
  PK4(p0, 0, pa0); PK4(p0, 8, pa1); PK4(p1, 0, pa2); PK4(p1, 8, pa3);
#undef PK4
}
template <bool full> __device__ __forceinline__ void qkt(f32x16& p0, f32x16& p1, const bf16* Ks, const bf16x8* qr, int r32, int hi, const int koff) {
  p0 = f32x16{}; p1 = f32x16{};
  for (int d0 = 0; d0 < 4; ++d0) { int cb = (d0 * 16 + hi * 8) * 2 + koff;
    bf16x8 b0 = *reinterpret_cast<const bf16x8*>((const char*)Ks + KSWZ(r32, cb));
    bf16x8 b1 = *reinterpret_cast<const bf16x8*>((const char*)Ks + KSWZ(32 + r32, cb));
    p0 = __builtin_amdgcn_mfma_f32_32x32x16_bf16(b0, qr[d0], p0, 0, 0, 0);
    p1 = __builtin_amdgcn_mfma_f32_32x32x16_bf16(b1, qr[d0], p1, 0, 0, 0); }
  if constexpr (full) {
  for (int d0 = 4; d0 < 8; ++d0) { int cb = (d0 * 16 + hi * 8) * 2;
    bf16x8 b0 = *reinterpret_cast<const bf16x8*>((const char*)Ks + KSWZ(r32, cb));
    bf16x8 b1 = *reinterpret_cast<const bf16x8*>((const char*)Ks + KSWZ(32 + r32, cb));
    p0 = __builtin_amdgcn_mfma_f32_32x32x16_bf16(b0, qr[d0], p0, 0, 0, 0);
    p1 = __builtin_amdgcn_mfma_f32_32x32x16_bf16(b1, qr[d0], p1, 0, 0, 0); } }
}
__device__ __forceinline__ int v_st(int k, int c) { const int kk = (k & ~0xC) | ((k & 4) << 1) | ((k & 8) >> 1); return ((kk >> 3) * 4 + (c >> 5)) * 512 + ((kk & 7) * 32 + (c & 31)) * 2; }
__device__ __forceinline__ int v_rd_base(int lane) { return ((lane & 3) << 3) | (((lane >> 2) & 3) << 6) | (((lane >> 4) & 1) << 5) | (((lane >> 5) & 1) << 8); }
constexpr int v_rd_off(int d0, int ks, int half) { return d0 * 512 + ks * 4096 + half * 2048; }
template <int OFF> __device__ __forceinline__ s16x4 tr_read(int vb) {
  s16x4 r; asm volatile("ds_read_b64_tr_b16 %0, %1 offset:%2" : "=&v"(r) : "v"(vb), "i"(OFF) : "memory"); return r;
}
template <int D0> __device__ __forceinline__ void pv_one(f32x16& od, int vb, bf16x8 pa0, bf16x8 pa1, bf16x8 pa2, bf16x8 pa3) {
  const s16x4 l0 = tr_read<v_rd_off(D0, 0, 0)>(vb), h0 = tr_read<v_rd_off(D0, 0, 1)>(vb), l1 = tr_read<v_rd_off(D0, 1, 0)>(vb), h1 = tr_read<v_rd_off(D0, 1, 1)>(vb);
  const s16x4 l2 = tr_read<v_rd_off(D0, 2, 0)>(vb), h2 = tr_read<v_rd_off(D0, 2, 1)>(vb), l3 = tr_read<v_rd_off(D0, 3, 0)>(vb), h3 = tr_read<v_rd_off(D0, 3, 1)>(vb);
  asm volatile("s_waitcnt lgkmcnt(0)" ::: "memory"); SBAR();
#define PK(L, H) (bf16x8){L[0], L[1], L[2], L[3], H[0], H[1], H[2], H[3]}
  od = __builtin_amdgcn_mfma_f32_32x32x16_bf16(pa0, PK(l0, h0), od, 0, 0, 0);
  od = __builtin_amdgcn_mfma_f32_32x32x16_bf16(pa1, PK(l1, h1), od, 0, 0, 0);
  od = __builtin_amdgcn_mfma_f32_32x32x16_bf16(pa2, PK(l2, h2), od, 0, 0, 0);
  od = __builtin_amdgcn_mfma_f32_32x32x16_bf16(pa3, PK(l3, h3), od, 0, 0, 0);
#undef PK
}
__device__ __forceinline__ void pv_d0(f32x16* o, int vb, bf16x8 pa0, bf16x8 pa1, bf16x8 pa2, bf16x8 pa3) {
  pv_one<0>(o[0], vb, pa0, pa1, pa2, pa3); pv_one<1>(o[1], vb, pa0, pa1, pa2, pa3); pv_one<2>(o[2], vb, pa0, pa1, pa2, pa3); pv_one<3>(o[3], vb, pa0, pa1, pa2, pa3);
}
struct AttnUnit {
  const bf16* Q; const bf16* K; const bf16* V; bf16* O;
  int ctx_row0, lat_row0, nctx, nt;
  int qpos0, kpos0;
  float C, thr_raw;
  int nsub, sub;
  float lam, post;
  const float* gsub;
  float sink; int has_sink;
  const float* rpb;
  float* stash;
};
#ifndef B_PIPE
#define B_PIPE 0
#endif
#ifndef ATT_SDEPTH
#define ATT_SDEPTH 1
#endif
#ifndef ATT_SDEPTH_FULL
#define ATT_SDEPTH_FULL 1
#endif
#ifndef ATT_SDEPTH_HALF
#define ATT_SDEPTH_HALF 2
#endif
constexpr int LDK = 128, LDO = 2048;
constexpr int SHM_V = 16384, SHM_K = 16384;
constexpr int ATT_WS_OFF = 2 * SHM_V + 2 * SHM_K, ATT_RPB_OFF = ATT_WS_OFF + NW_ * 64 * 4, ATT_LDS = ATT_RPB_OFF + 2048;

template <int MODE>
__device__ __forceinline__ void mask_tile(f32x16& p0, f32x16& p1, int j, const AttnUnit& u, int wid, int r32, int hi, const float* rpbL) {
  if (MODE == 0) return;
  if (j < u.nctx) return;
  int qi = u.qpos0 + wid * 32 + r32; asm volatile("" : "+v"(qi));
  if (MODE == 2) {
    const int kb = u.kpos0 + (j - u.nctx) * 64 + 4 * hi - qi;
#pragma unroll
    for (int r = 0; r < 16; ++r) { const int d0 = kb + (r & 3) + 8 * (r >> 2), d1 = d0 + 32;
      p0[r] = (d0 <= 128 && d0 >= -128) ? p0[r] : -1e30f; p1[r] = (d1 <= 128 && d1 >= -128) ? p1[r] : -1e30f; }
  } else {
    const int i = (u.kpos0 >> 6) + (j - u.nctx);
    const int qr_ = qi >> 6, qc = qi & 63;
    int rs = qr_ - 4; rs = rs < 0 ? 0 : (rs > 24 ? 24 : rs);
    int cs = qc - 8; cs = cs < 0 ? 0 : (cs > 48 ? 48 : cs);
    const bool rowok = (i >= rs) && (i < rs + 8);
    const int bbase = (i - qr_ + 7) * 31 + 15 - qc;
#pragma unroll
    for (int r = 0; r < 16; ++r) { const int c0 = (r & 3) + 8 * (r >> 2) + 4 * hi, c1 = c0 + 32;
        const bool ok0 = rowok && (unsigned)(c0 - cs) < 16u, ok1 = rowok && (unsigned)(c1 - cs) < 16u;
        const float b0 = rpbL[ok0 ? bbase + c0 : 0], b1 = rpbL[ok1 ? bbase + c1 : 0];
        p0[r] = ok0 ? p0[r] + b0 : -1e30f; p1[r] = ok1 ? p1[r] + b1 : -1e30f;
        if (r & 1) __builtin_amdgcn_sched_barrier(0); }
  }
}

#ifdef USE_SGB
#define SGB_QK() do { _Pragma("unroll") for (int i_ = 0; i_ < (FULL ? 16 : 8); ++i_) { __builtin_amdgcn_sched_group_barrier(0x008, 1, 0); __builtin_amdgcn_sched_group_barrier(0x100, 1, 0); __builtin_amdgcn_sched_group_barrier(0x002, SGB_NV, 0); } } while (0)
#else
#define SGB_QK() do { } while (0)
#endif
#ifndef SGB_NV
#define SGB_NV 6
#endif
template <int MODE, bool FULL>
__device__ __forceinline__ void attn_unit(const AttnUnit& u, char* lds) {
  using St = Stage<bf16>;
  constexpr int SDEPTH = (MODE == 0) ? (FULL ? ATT_SDEPTH_FULL : ATT_SDEPTH_HALF) : ATT_SDEPTH;
  int tid = threadIdx.x; asm volatile("" : "+v"(tid));
  const int wid = tid >> 6, lane = tid & 63, r32 = lane & 31, hi = lane >> 5;
  bf16* V_lds = (bf16*)lds; bf16* K_lds = (bf16*)(lds + 2 * SHM_V);
  float* ws = (float*)(lds + ATT_WS_OFF) + wid * 64; float* li_l = ws; float* al_l = ws + 32;
  float* rpbL = (float*)(lds + ATT_RPB_OFF);
#ifdef T3
  const float C = 0.1275174f, thr_raw = 90.5f;
#else
  const float C = u.C, thr_raw = u.thr_raw;
#endif
  __syncthreads();
  if (MODE == 1) { if (tid < 465) rpbL[tid] = u.rpb[tid] * 11.313708498984761f; }
  const int sr = tid >> 4, sc = (tid & 15) * 8, vst0 = v_st(sr, sc), vst1 = v_st(32 + sr, sc);
  const int vb0 = (int)(uintptr_t)V_lds + v_rd_base(lane);
  const unsigned kvoff = (unsigned)(sr * LDK + sc);
  const int NT = u.nt;
#define TROW(j) ((j) < u.nctx ? u.ctx_row0 + (j) * 64 : u.lat_row0 + ((j) - u.nctx) * 64)
  const int sub = u.sub; {
  float m_reg = -1e29f, l_reg = 0; f32x16 o[4] = {}; bf16x8 qr[8];
  const bf16* Qw = u.Q + (long)(wid * QBLK + r32) * LDK + hi * 8;
  constexpr bool qfull = FULL; const int koff = qfull ? 0 : sub * 128, qoff = qfull ? 0 : sub * 64;
#pragma unroll
  for (int d0 = 0; d0 < 8; ++d0) qr[d0] = St::ld8(Qw + (d0 < 4 ? qoff : 0) + d0 * 16);
  struct { typename St::T vs0, vs1, ks0, ks1; } sr_[SDEPTH];
#define SLOAD(i, tj) do { const long ro_ = (long)TROW(tj) * LDK; const bf16* kb_ = u.K + ro_; const bf16* vb_ = u.V + ro_; sr_[i].vs0 = St::ld8(vb_ + kvoff); sr_[i].vs1 = St::ld8(vb_ + 32 * LDK + kvoff); \
    sr_[i].ks0 = St::ld8(kb_ + kvoff); sr_[i].ks1 = St::ld8(kb_ + 32 * LDK + kvoff); } while (0)
#define SWRITE(b, i) do { *(bf16x8*)((char*)V_lds + (b) * SHM_V + vst0) = St::tobf(sr_[i].vs0);          \
    *(bf16x8*)((char*)V_lds + (b) * SHM_V + vst1) = St::tobf(sr_[i].vs1); int kc = sc * 2;               \
    *(bf16x8*)((char*)K_lds + (b) * SHM_K + KSWZ(sr, kc)) = St::tobf(sr_[i].ks0);                       \
    *(bf16x8*)((char*)K_lds + (b) * SHM_K + KSWZ(32 + sr, kc)) = St::tobf(sr_[i].ks1); } while (0)
#define SWAIT() do { if (SDEPTH == 2) asm volatile("s_waitcnt vmcnt(4)" ::: "memory"); else asm volatile("s_waitcnt vmcnt(0)" ::: "memory"); } while (0)
#define RESC(a) do { if (__any((a) < 1.f)) { if (hi == 0) al_l[r32] = (a); asm volatile("s_waitcnt lgkmcnt(0)" ::: "memory"); \
    for (int d = 0; d < 4; ++d) for (int r = 0; r < 16; ++r) o[d][r] *= al_l[crow(r, hi)]; } } while (0)
  f32x16 pA0, pA1, pB0, pB1; float mnA, mnB, alA, alB; bf16x8 pa0, pa1, pa2, pa3;
  constexpr int SE = 0, SO = SDEPTH - 1;
  if constexpr (MODE == 1 && !B_PIPE) {
  __syncthreads();
  SLOAD(SE, 0); asm volatile("s_waitcnt vmcnt(0)" ::: "memory"); SWRITE(0, SE); __syncthreads();
  for (int j = 0; j < NT; ++j) {
    const int bsel = j & 1;
    if (j + 1 < NT) SLOAD(SE, j + 1);
    SBAR(); qkt<FULL>(pA0, pA1, (bf16*)((char*)K_lds + bsel * SHM_K), qr, r32, hi, koff);
    mask_tile<MODE>(pA0, pA1, j, u, wid, r32, hi, rpbL); partialSM(pA0, pA1, m_reg, mnA, alA, C, thr_raw);
    RESC(alA);
    finishSM(pA0, pA1, alA, l_reg, pa0, pa1, pa2, pa3); SBAR();
    pv_d0(o, vb0 + bsel * (int)SHM_V, pa0, pa1, pa2, pa3);
    if (j + 1 < NT) { asm volatile("s_waitcnt vmcnt(0)" ::: "memory"); if (bsel) SWRITE(0, SE); else SWRITE(1, SE); }
    __syncthreads();
  }
  } else {
  __syncthreads();
  SLOAD(SE, 0); asm volatile("s_waitcnt vmcnt(0)" ::: "memory"); SWRITE(0, SE);
  if (SDEPTH == 1) SLOAD(SO, 1);
  __syncthreads();
  qkt<FULL>(pA0, pA1, K_lds, qr, r32, hi, koff); mask_tile<MODE>(pA0, pA1, 0, u, wid, r32, hi, rpbL); partialSM(pA0, pA1, m_reg, mnA, alA, C, thr_raw);
  if (SDEPTH == 2) { SLOAD(SO, 1); if (2 < NT) SLOAD(SE, 2); }
  SWAIT(); SWRITE(1, SO); __syncthreads();
  for (int j = 1; j + 1 < NT; j += 2) {
#ifdef EARLY_LOAD
    SLOAD(SO, j + SDEPTH); SBAR();
#endif
    SBAR(); qkt<FULL>(pB0, pB1, (bf16*)((char*)K_lds + SHM_K), qr, r32, hi, koff);
    finishSM(pA0, pA1, alA, l_reg, pa0, pa1, pa2, pa3); SGB_QK(); SBAR();
#ifndef EARLY_LOAD
    SLOAD(SO, j + SDEPTH); SBAR();
#endif
    pv_d0(o, vb0, pa0, pa1, pa2, pa3); mask_tile<MODE>(pB0, pB1, j, u, wid, r32, hi, rpbL); partialSM(pB0, pB1, m_reg, mnB, alB, C, thr_raw);
    __syncthreads(); SWAIT(); SWRITE(0, SE);
    RESC(alB); __syncthreads();
#ifdef EARLY_LOAD
    if (SDEPTH == 1 || j + 3 < NT) SLOAD(SE, j + 1 + SDEPTH); SBAR();
#endif
    SBAR(); qkt<FULL>(pA0, pA1, K_lds, qr, r32, hi, koff);
    finishSM(pB0, pB1, alB, l_reg, pa0, pa1, pa2, pa3); SGB_QK(); SBAR();
#ifndef EARLY_LOAD
    if (SDEPTH == 1 || j + 3 < NT) SLOAD(SE, j + 1 + SDEPTH); SBAR();
#endif
    pv_d0(o, vb0 + (int)SHM_V, pa0, pa1, pa2, pa3); mask_tile<MODE>(pA0, pA1, j + 1, u, wid, r32, hi, rpbL); partialSM(pA0, pA1, m_reg, mnA, alA, C, thr_raw);
    __syncthreads(); SWAIT(); SWRITE(1, SO);
    RESC(alA); __syncthreads();
  }
  SBAR(); qkt<FULL>(pB0, pB1, (bf16*)((char*)K_lds + SHM_K), qr, r32, hi, koff);
  finishSM(pA0, pA1, alA, l_reg, pa0, pa1, pa2, pa3); SBAR();
  pv_d0(o, vb0, pa0, pa1, pa2, pa3); mask_tile<MODE>(pB0, pB1, NT - 1, u, wid, r32, hi, rpbL); partialSM(pB0, pB1, m_reg, mnB, alB, C, thr_raw);
  __syncthreads(); RESC(alB);
  finishSM(pB0, pB1, alB, l_reg, pa0, pa1, pa2, pa3); SBAR();
  pv_d0(o, vb0 + (int)SHM_V, pa0, pa1, pa2, pa3);
  }
  asm volatile("s_waitcnt vmcnt(0)" ::: "memory");
  if (u.has_sink) l_reg += __builtin_amdgcn_exp2f(u.sink * 1.4426950408889634f - m_reg * C);
  if (hi == 0) li_l[r32] = l_reg; asm volatile("s_waitcnt lgkmcnt(0)" ::: "memory");
  float rli[16];
#pragma unroll
  for (int r = 0; r < 16; ++r) rli[r] = __builtin_amdgcn_rcpf(li_l[crow(r, hi)]);
#pragma unroll
  for (int r = 0; r < 16; ++r)
#pragma unroll
    for (int d0 = 0; d0 < 4; ++d0) o[d0][r] *= rli[r];
  if (u.nsub == 2) {
    float* sp = u.stash + (long)u.sub * (256 * 128) + (long)(wid * QBLK) * 128 + r32;
#pragma unroll
    for (int r = 0; r < 16; ++r)
#pragma unroll
      for (int d0 = 0; d0 < 4; ++d0) sp[crow(r, hi) * 128 + d0 * 32] = o[d0][r];
  } else {
    bf16* Ow = u.O + (long)(wid * QBLK) * LDO + r32;
#pragma unroll
    for (int r = 0; r < 16; ++r)
#pragma unroll
      for (int d0 = 0; d0 < 4; ++d0) Ow[(long)crow(r, hi) * LDO + d0 * 32] = (bf16)f2bf(o[d0][r]);
  }
  }
#undef TROW
#undef SLOAD
#undef SWRITE
#undef SWAIT
#undef RESC
}

__device__ __forceinline__ void unit_finish(const AttnUnit& u) {
  int tid = threadIdx.x; asm volatile("" : "+v"(tid));
  const int wid = tid >> 6, lane = tid & 63;
  if (u.nsub != 2 || u.sub == 0) return;
  __syncthreads();
  const float* s0 = u.stash + (long)(wid * QBLK) * 128 + 2 * lane; const float* s1 = s0 + 256 * 128;
  unsigned* op = (unsigned*)(u.O + (long)(wid * QBLK) * LDO) + lane;
  if (u.nsub == 2) {
    const float g0 = u.gsub[2 * lane] * u.post, g1 = u.gsub[2 * lane + 1] * u.post;
#pragma unroll 4
    for (int r = 0; r < 32; ++r) {
      const float a0 = s0[r * 128], a1 = s0[r * 128 + 1], b0 = s1[r * 128], b1 = s1[r * 128 + 1];
      const float v0 = a0 - u.lam * b0, v1 = a1 - u.lam * b1;
      float ss = v0 * v0 + v1 * v1;
      ss = ::wave_sum(ss);
      const float rn = 1.0f / sqrtf(ss * (1.0f / 128.0f) + 1e-6f);
      op[(long)r * (LDO / 2)] = pk2(v0 * rn * g0, v1 * rn * g1);
    }
  } else {
#pragma unroll 8
    for (int r = 0; r < 32; ++r) op[(long)r * (LDO / 2)] = pk2(s0[r * 128], s0[r * 128 + 1]);
  }
}
#undef SBAR
#undef KSWZ
}
struct Args { const float* in[22]; float* out; unsigned char* ws; int ph_lo, ph_hi; };
enum { I_X = 0, I_C, I_CTX, I_CCTX, I_GMIX, I_GMLP, I_WMOD, I_BMOD, I_WIN, I_WOUT, I_GQ, I_GK, I_RPB, I_LQ1, I_LK1, I_LQ2, I_LK2, I_GSUB, I_SINK, I_WUP, I_WDN, I_GFIN };
typedef float f32x4g __attribute__((ext_vector_type(4)));
typedef unsigned v4u __attribute__((ext_vector_type(4)));

__device__ __forceinline__ void transpose_item(const float* W, int K, int N, bf16* WT, int ldt, LAS float* scr, int item, int lane) {
    const int nblk = N / 32, kb = item / nblk, nb = item % nblk, k0 = 64 * kb, n0 = 32 * nb;
#pragma unroll 8
    for (int i = 0; i < 32; ++i) { const int kk = 2 * i + (lane >> 5); scr[kk * 33 + (lane & 31)] = W[(size_t)(k0 + kk) * N + n0 + (lane & 31)]; }
    asm volatile("s_waitcnt lgkmcnt(0)" ::: "memory");
    const int c = lane & 7;
#pragma unroll
    for (int j = 0; j < 4; ++j) { const int n = (lane >> 3) + 8 * j; const LAS float* s = scr + (8 * c) * 33 + n;
        v4u o; o.x = pk2(s[0 * 33], s[1 * 33]); o.y = pk2(s[2 * 33], s[3 * 33]); o.z = pk2(s[4 * 33], s[5 * 33]); o.w = pk2(s[6 * 33], s[7 * 33]);
        *(v4u*)(WT + (size_t)(n0 + n) * ldt + k0 + 8 * c) = o; }
    asm volatile("s_waitcnt lgkmcnt(0)" ::: "memory");
}

__device__ __forceinline__ void weight_transposes(const Args& a, unsigned char* lds_, int l, int wg, int nwg_) {
    int tid_ = threadIdx.x; asm volatile("" : "+v"(tid_)); const int lane = tid_ & 63, wave = tid_ >> 6; const int gw = wg * NWAVES + wave, NGW = nwg_ * NWAVES;
    LAS float* scr = (LAS float*)((LAS unsigned char*)lds_ + wave * 16384);
    constexpr int I_IN = (DM / 64) * (PW / 32), I_OUT = (DM / 64) * (DM / 32), I_UP = (DM / 64) * (HID / 32), I_DN = (HID / 64) * (DM / 32), I_L = I_IN + I_OUT + I_UP + I_DN;
    bf16* wt = (bf16*)(a.ws + WS_WT + (size_t)l * WL_B);
    for (int it = gw; it < I_L; it += NGW) {
        int r = it;
        if (r < I_IN) { transpose_item(a.in[I_WIN] + (size_t)l * DM * PW, DM, PW, wt, DM, scr, r, lane); continue; } r -= I_IN;
        if (r < I_OUT) { transpose_item(a.in[I_WOUT] + (size_t)l * DM * DM, DM, DM, (bf16*)((unsigned char*)wt + WIN_B), DM, scr, r, lane); continue; } r -= I_OUT;
        if (r < I_UP) { transpose_item(a.in[I_WUP] + (size_t)l * DM * HID, DM, HID, (bf16*)((unsigned char*)wt + WIN_B + WOUT_B), DM, scr, r, lane); continue; } r -= I_UP;
        transpose_item(a.in[I_WDN] + (size_t)l * HID * DM, HID, DM, (bf16*)((unsigned char*)wt + WIN_B + WOUT_B + WUP_B), HIDP, scr, r, lane);
    }
}

__device__ __forceinline__ void phase_prologue(const Args& a, unsigned char* lds_, int G, int vcu) {
    int tid_ = threadIdx.x; asm volatile("" : "+v"(tid_)); const int tid = tid_, lane = tid & 63, wave = tid >> 6;
    float* cond = (float*)lds_;
    float* part = (float*)(lds_ + 9 * 2048 * 4);
    __syncthreads();
    for (int i = tid; i < 9 * 2048; i += NTHREADS) { const int r = i >> 11, k = i & 2047; const float v = r < 8 ? a.in[I_C][r * 2048 + k] : a.in[I_CCTX][k]; cond[i] = v / (1.0f + expf(-v)); }
    __syncthreads();
    float* MOD = (float*)(a.ws + WS_MOD);
    for (int item = blockIdx.x; item < 768; item += G) {
        const int l = item / 384, n0 = (item % 384) * 32;
        const float* W = a.in[I_WMOD] + (size_t)l * 2048 * MODW + n0;
        const int kq = tid >> 3, c4 = tid & 7;
        float acc[9][4];
#pragma unroll
        for (int r = 0; r < 9; ++r)
#pragma unroll
            for (int j = 0; j < 4; ++j) acc[r][j] = 0.f;
#pragma unroll 2
        for (int i0 = 0; i0 < 32; i0 += 4) {
            f32x4g w[4];
#pragma unroll
            for (int i = 0; i < 4; ++i) w[i] = *(const f32x4g*)(W + (size_t)(kq * 32 + i0 + i) * MODW + c4 * 4);
#pragma unroll
            for (int r = 0; r < 9; ++r) { const f32x4g cv = *(const f32x4g*)(cond + r * 2048 + kq * 32 + i0);
#pragma unroll
                for (int i = 0; i < 4; ++i)
#pragma unroll
                    for (int j = 0; j < 4; ++j) acc[r][j] += cv[i] * w[i][j]; }
        }
#pragma unroll
        for (int r = 0; r < 9; ++r)
#pragma unroll
            for (int j = 0; j < 4; ++j) { float v = acc[r][j]; v = sum_xor<8>(v); v = sum_xor<16>(v); v = sum_xor<32>(v); if (lane < 8) part[(wave * 9 + r) * 32 + c4 * 4 + j] = v; }
        __syncthreads();
        if (tid < 288) { const int r = tid >> 5, n = tid & 31; float s = 0.f;
#pragma unroll
            for (int w = 0; w < 8; ++w) s += part[(w * 9 + r) * 32 + n];
            MOD[(size_t)(l * 9 + r) * MODW + n0 + n] = s + a.in[I_BMOD][l * MODW + n0 + n]; }
        __syncthreads();
    }
    weight_transposes(a, lds_, 0, vcu, G); weight_transposes(a, lds_, 1, vcu, G);
    float* cosH = (float*)(a.ws + WS_ROPE); float* sinH = cosH + 2048 * 64; float* cosD = sinH + 2048 * 64; float* sinD = cosD + 2048 * 32;
    for (int i = blockIdx.x * NTHREADS + tid; i < 2048 * 96; i += G * NTHREADS) {
        if (i < 2048 * 64) { const int t = i >> 6, p = i & 63; const float pos = (float)(p < 32 ? (t >> 6) : (t & 63)); const float f = powf(10000.0f, -(float)(p & 31) / 32.0f); const float ang = pos * f; cosH[i] = cosf(ang); sinH[i] = sinf(ang); }
        else { const int k = i - 2048 * 64, t = k >> 5, p = k & 31; const float pos = (float)(p < 16 ? (t >> 6) : (t & 63)); const float f = powf(10000.0f, -(float)(p & 15) / 16.0f); const float ang = pos * f; cosD[k] = cosf(ang); sinD[k] = sinf(ang); }
    }
}

__device__ __forceinline__ void phase_norm(const float* xa, const float* xb, int M, const float* g, const float* modl, int shift_slot, int scale_slot, bf16* out, const float* part, const float* pgate, float* wb, bool xb_src, int G, int vcu) {
    int tid_ = threadIdx.x; asm volatile("" : "+v"(tid_)); const int lane = tid_ & 63, wave = tid_ >> 6; const int gw = vcu * NWAVES + wave, NGW = G * NWAVES;
    for (int m = gw; m < M; m += NGW) {
        const float* xr = m < MX ? xa + (size_t)m * DM : xb + (size_t)(m - MX) * DM; const int b = m < MX ? (m >> 11) : 8;
        const f32x4g* xp = (const f32x4g*)xr + lane; f32x4g v[8]; float s = 0.f;
        if (xb_src && m < MX) { const unsigned long long* bp = (const unsigned long long*)(out + (size_t)m * DM) + lane;
#pragma unroll
            for (int j = 0; j < 8; ++j) { const unsigned long long w = bp[64 * j]; v[j].x = bf2f((unsigned)w & 0xffffu); v[j].y = bf2f(((unsigned)w) >> 16); v[j].z = bf2f((unsigned)(w >> 32) & 0xffffu); v[j].w = bf2f((unsigned)(w >> 48)); } }
        else {
#pragma unroll
            for (int j = 0; j < 8; ++j) v[j] = xp[64 * j]; }
        if (part != nullptr && m >= MX) { const f32x4g* pp = (const f32x4g*)(part + (size_t)(m - MX) * DM) + lane; const f32x4g* pg = (const f32x4g*)pgate + lane;
#pragma unroll
            for (int j = 0; j < 8; ++j) { const f32x4g q = (pp[64 * j] + pp[64 * j + (size_t)MC * DM / 4]) + (pp[64 * j + 2 * ((size_t)MC * DM / 4)] + pp[64 * j + 3 * ((size_t)MC * DM / 4)]); v[j] += pg[64 * j] * q; }
            if (wb != nullptr) { f32x4g* wp = (f32x4g*)(wb + (size_t)(m - MX) * DM) + lane;
#pragma unroll
                for (int j = 0; j < 8; ++j) wp[64 * j] = v[j]; } }
#pragma unroll
        for (int j = 0; j < 8; ++j) s += (v[j].x * v[j].x + v[j].y * v[j].y) + (v[j].z * v[j].z + v[j].w * v[j].w);
        const float rstd = 1.0f / sqrtf(wave_sum(s) * (1.0f / DM) + NORM_EPS);
        const f32x4g* gp = (const f32x4g*)g + lane; const f32x4g* shp = (const f32x4g*)(modl + (size_t)b * MODW + shift_slot * DM) + lane; const f32x4g* scp = (const f32x4g*)(modl + (size_t)b * MODW + scale_slot * DM) + lane;
        unsigned long long* o8 = (unsigned long long*)(out + (size_t)m * DM) + lane;
#pragma unroll
        for (int j = 0; j < 8; ++j) { const f32x4g gg = gp[64 * j], sh = shp[64 * j], sc = scp[64 * j]; const f32x4g y = (v[j] * rstd) * gg * (sc + 1.0f) + sh;
            o8[64 * j] = (unsigned long long)pk2(y.x, y.y) | ((unsigned long long)pk2(y.z, y.w) << 32); }
    }
}
__device__ __forceinline__ void phase_final(const float* x, const float* g, float* out, int G, int vcu) {
    int tid_ = threadIdx.x; asm volatile("" : "+v"(tid_)); const int lane = tid_ & 63, wave = tid_ >> 6; const int gw = vcu * NWAVES + wave, NGW = G * NWAVES;
    for (int m = gw; m < MX; m += NGW) {
        const f32x4g* xp = (const f32x4g*)(x + (size_t)m * DM) + lane; f32x4g v[8]; float s = 0.f;
#pragma unroll
        for (int j = 0; j < 8; ++j) { v[j] = xp[64 * j]; s += (v[j].x * v[j].x + v[j].y * v[j].y) + (v[j].z * v[j].z + v[j].w * v[j].w); }
        const float rstd = 1.0f / sqrtf(wave_sum(s) * (1.0f / DM) + NORM_EPS);
        const f32x4g* gp = (const f32x4g*)g + lane; f32x4g* op = (f32x4g*)(out + (size_t)m * DM) + lane;
#pragma unroll
        for (int j = 0; j < 8; ++j) op[64 * j] = (v[j] * rstd) * gp[64 * j];
    }
}

__device__ __forceinline__ void phase_qkprep(bf16* P, const float* gq, const float* gk, const float* rope, int G, int vcu) {
    int tid_ = threadIdx.x; asm volatile("" : "+v"(tid_)); const int lane = tid_ & 63, wave = tid_ >> 6; const int gw = vcu * NWAVES + wave, NGW = G * NWAVES;
    const float* cosH = rope; const float* sinH = cosH + 2048 * 64; const float* cosD = sinH + 2048 * 64; const float* sinD = cosD + 2048 * 32;
    const float gq0 = gq[2 * lane], gq1 = gq[2 * lane + 1], gk0 = gk[2 * lane], gk1 = gk[2 * lane + 1];
    for (int m = gw; m < MT; m += NGW) {
        const bool lat = m < MX; const int pos = m & 2047;
        unsigned* row = (unsigned*)(P + (size_t)m * PW) + lane;
        float cH = 1.f, sH = 0.f, cD = 1.f, sD = 0.f;
        if (lat) { cH = cosH[pos * 64 + lane]; sH = sinH[pos * 64 + lane]; cD = cosD[pos * 32 + (lane & 31)]; sD = sinD[pos * 32 + (lane & 31)]; }
#pragma unroll
        for (int blk = 0; blk < 6; ++blk) {
            const unsigned w = row[blk * 64]; float x0 = bf2f(w & 0xffffu), x1 = bf2f(w >> 16);
            const float ss = wave_sum(x0 * x0 + x1 * x1); const float rn = 1.0f / sqrtf(ss * (1.0f / 128.0f) + NORM_EPS);
            x0 = x0 * rn * (blk < 4 ? gq0 : gk0); x1 = x1 * rn * (blk < 4 ? gq1 : gk1);
            const float y0 = x0 * cH - x1 * sH, y1 = x0 * sH + x1 * cH;
            row[blk * 64] = pk2(y0, y1);
        }
        if (lat) {
#pragma unroll
            for (int blk = 0; blk < 8; ++blk) {
                const unsigned w = row[(2560 / 2) + blk * 64]; const float x0 = bf2f(w & 0xffffu), x1 = bf2f(w >> 16);
                row[(2560 / 2) + blk * 64] = pk2(x0 * cD - x1 * sD, x0 * sD + x1 * cD);
            }
#pragma unroll
            for (int blk = 0; blk < 6; ++blk) {
                const unsigned w = row[(4096 / 2) + blk * 64]; const float x0 = bf2f(w & 0xffffu), x1 = bf2f(w >> 16);
                row[(4096 / 2) + blk * 64] = pk2(x0 * cH - x1 * sH, x0 * sH + x1 * cH);
            }
        }
    }
}

#ifndef AM1
#define AM1 1
#define AM2 2
#endif
__device__ __forceinline__ void phase_attention(const Args& a, int layer, unsigned char* lds_, int G, int vcu) {
    bf16* P = (bf16*)(a.ws + WS_P); bf16* AO = (bf16*)(a.ws + WS_AO);
    const float LOG2E = 1.4426950408889634f;
    const float lam_init = 0.8f - 0.6f * expf(-0.3f * (float)layer);
    float lam;
    { int lane = threadIdx.x & 63; asm volatile("" : "+v"(lane)); const float* q1 = a.in[I_LQ1] + layer * 64, *k1 = a.in[I_LK1] + layer * 64, *q2 = a.in[I_LQ2] + layer * 64, *k2 = a.in[I_LK2] + layer * 64;
      const float s1 = wave_sum(q1[lane] * k1[lane]), s2 = wave_sum(q2[lane] * k2[lane]); lam = expf(s1) - expf(s2) + lam_init; lam = __builtin_bit_cast(float, __builtin_amdgcn_readfirstlane(__builtin_bit_cast(int, lam))); }
    const int nround = layer == 0 ? 7 : 5;
    for (int vu = vcu; vu < 256; vu += G) {
    for (int round = 0; round < nround; ++round) {
        att::AttnUnit u; int type, b, h, qb; bool isctx = false; u.sub = 0;
        if (round < 5) { b = vu >> 5; h = (vu >> 3) & 3; qb = vu & 7;
            const int rr = (h < 2) ? round : (round + 2) % 5;
            type = rr < 2 ? 2 : (rr == 2 ? 0 : (rr == 3 ? 1 : 3)); u.sub = rr == 1 ? 1 : 0; }
        else { if (vu & 1) continue; const int idx = vu >> 1; b = idx >> 4; type = (idx >> 2) & 3; h = idx & 3; qb = 0; isctx = true; if (round == 6) { if (type != 2) continue; u.sub = 1; } }
        const int kvh = (type == 0 || type == 3) ? (h >> 1) : h;
        const int qcol = type == 0 ? h * 128 : type == 1 ? 1024 + h * 128 : type == 2 ? 2560 + h * 128 : 4096 + h * 128;
        const int kcol = type == 0 ? 512 + kvh * 128 : type == 1 ? 1536 + kvh * 128 : type == 2 ? 3072 + kvh * 128 : 4608 + kvh * 128;
        const int vcol = type == 0 ? 768 + kvh * 128 : type == 1 ? 2048 + kvh * 128 : type == 2 ? 3584 + kvh * 128 : 4864 + kvh * 128;
        const int ocol = type * 512 + h * 128;
        const int qrow0 = isctx ? MX + b * CTXL : b * SEQ + qb * 256;
        u.Q = P + ((size_t)(qcol >> 7) * MT + qrow0) * 128; u.K = P + (size_t)(kcol >> 7) * MT * 128; u.V = P + (size_t)(vcol >> 7) * MT * 128; u.O = AO + (size_t)qrow0 * DM + ocol;
        u.ctx_row0 = MX + b * CTXL; u.nctx = 4; u.qpos0 = qb * 256;
        int t_lo = 0, nlat = 32;
        if (isctx) nlat = 0;
        else if (type == 1) { const int r0 = qb * 4; int lo = r0 - 4; lo = lo < 0 ? 0 : (lo > 24 ? 24 : lo); int hi = r0 - 1; hi = hi < 0 ? 0 : (hi > 24 ? 24 : hi); hi += 8; if ((hi - lo) & 1) hi += 1; t_lo = lo; nlat = hi - lo; }
        else if (type == 3) { int lo = qb * 4 - 2; lo = lo < 0 ? 0 : lo; int hi = qb * 4 + 6; hi = hi > 32 ? 32 : hi; t_lo = lo; nlat = hi - lo; }
        u.lat_row0 = b * SEQ + t_lo * 64; u.kpos0 = t_lo * 64; u.nt = 4 + nlat;
        const float scale = type == 2 ? 0.125f : 0.088388347648318440f;
        u.C = scale * LOG2E; u.thr_raw = 8.0f / scale;
        u.nsub = type == 2 ? 2 : 1; u.lam = lam; u.post = 1.0f - lam_init; u.gsub = a.in[I_GSUB] + layer * 128;
        u.has_sink = type == 3; u.sink = type == 3 ? a.in[I_SINK][layer * 4 + h] : 0.f;
        u.rpb = a.in[I_RPB] + (size_t)(layer * 4 + h) * 465;
        u.stash = (float*)(a.ws + WS_STASH) + (size_t)blockIdx.x * 2 * 256 * 128;
#ifdef ATT_DUP_ROUND
        for (int dup_ = 0; dup_ < (round == ATT_DUP_ROUND ? 2 : 1); ++dup_) {
#else
        {
#endif
        if (!isctx && type == 1) att::attn_unit<AM1, true>(u, (char*)lds_);
        else if (!isctx && type == 3) att::attn_unit<AM2, true>(u, (char*)lds_);
        else if (type == 2) att::attn_unit<0, false>(u, (char*)lds_);
        else att::attn_unit<0, true>(u, (char*)lds_);
        att::unit_finish(u);
        }
    }
    }
}
#ifndef PHMASK
#define PHMASK 1023
#endif
#ifndef REP_ATT
#define REP_ATT 1
#endif
#ifndef REP_UP
#define REP_UP 1
#endif
#ifndef REP_IN
#define REP_IN 1
#endif
#ifndef REP_PRO
#define REP_PRO 1
#endif
#ifndef REP_SYNC
#define REP_SYNC 1
#endif
#ifndef REP_NORM
#define REP_NORM 1
#endif
#ifndef REP_INQK
#define REP_INQK 1
#endif
#ifndef REP_DN
#define REP_DN 1
#endif
#ifndef DN_WGM
#define DN_WGM 4
#endif
#ifndef USE_XB
#define USE_XB 0
#endif
#ifndef RES_SP2
#define RES_SP2 true
#endif
#ifndef MK_COOP
#define MK_COOP 1
#endif
constexpr int N_PHASES = 18;
__global__ void __launch_bounds__(NTHREADS) fwd_kernel(Args a) {
    extern __shared__ __attribute__((aligned(16))) unsigned char lds[];
    cg::grid_group grid = cg::this_grid();
    const int G = gridDim.x, bx = blockIdx.x;
    const int vcu = (G % 8 == 0) ? (bx % 8) * (G / 8) + bx / 8 : bx;
#define IN(k) (a.ph_lo <= (k) && (k) < a.ph_hi)
#define SEAM(k) do { if (IN(k) && IN((k) + 1)) for (int rs_ = 0; rs_ < REP_SYNC; ++rs_) { if (a.ph_lo < 0) grid.sync(); else xcd_barrier(xbar); }     } while (0)
    unsigned char* ws = a.ws;
    volatile LAS unsigned* xst = (volatile LAS unsigned*)((LAS unsigned char*)lds + 131072 + 64);
    if (threadIdx.x < 2) xst[threadIdx.x] = 0u;
    __syncthreads();
    XcdBarrier xbar; xbar.bar = (unsigned*)ws; xbar.x = 0; xbar.st = nullptr;
    if (a.ph_hi - a.ph_lo > 1) xbar = xcd_barrier_post((unsigned*)ws, xst);
    #if PHMASK & 1
    if (IN(0)) for (int rep_ = 0; rep_ < REP_PRO; ++rep_) phase_prologue(a, lds, G, vcu);
#endif
    SEAM(0);
    for (int l = 0; l < 2; ++l) {
        const int pb = 1 + 8 * l;
        asm volatile("" : "+s"(ws));
        float* X = (float*)(ws + WS_X); bf16* H0 = (bf16*)(ws + WS_H0); bf16* P = (bf16*)(ws + WS_P); bf16* AO = (bf16*)(ws + WS_AO); bf16* HM = (bf16*)(ws + WS_BIG);
        const float* modl = (const float*)(ws + WS_MOD) + (size_t)l * 9 * MODW;
        const bf16* Win = (const bf16*)(ws + WS_WT + (size_t)l * WL_B); const bf16* Wout = (const bf16*)((const unsigned char*)Win + WIN_B);
        const bf16* Wup = (const bf16*)((const unsigned char*)Wout + WOUT_B); const bf16* Wdn = (const bf16*)((const unsigned char*)Wup + WUP_B);
        const float* rX = l == 0 ? a.in[I_X] : X; const float* rC = l == 0 ? a.in[I_CTX] : X + (size_t)MX * DM;
        const int M2 = l == 0 ? MT : MX;
#if PHMASK & 2
        if (IN(pb + 0)) for (int rep_ = 0; rep_ < REP_NORM; ++rep_) phase_norm(rX, rC, MT, a.in[I_GMIX] + l * DM, modl, 0, 1, H0, l == 1 ? (const float*)(ws + WS_STASH) : nullptr, (const float*)(ws + WS_MOD) + 8 * MODW + 5 * DM, nullptr, USE_XB && l == 1, G, vcu);
#endif
        SEAM(pb + 0);
        for (int rq_ = 0; rq_ < REP_INQK; ++rq_) {
#if PHMASK & 4
        if (IN(pb + 1)) for (int rep_ = 0; rep_ < REP_IN; ++rep_) { pg8::Gemm g{H0, Win, MT, PW, DM, DM}; pg8::StaticOrder S; S.init(MT, PW, G, bx); pg8::EpiInProj E{P, MT, a.in[I_GQ] + l * 128, a.in[I_GK] + l * 128, (const float*)(ws + WS_ROPE), (LAS float*)((LAS unsigned char*)lds + 131072 + 1024)};
            pg8::gemm_phase<pg8::EpiInProj, pg8::StaticOrder, true, true>((LAS unsigned char*)lds, g, S, E); }
#endif
        SEAM(pb + 1);
        }
#if PHMASK & 16
        if (IN(pb + 3)) for (int rep_ = 0; rep_ < REP_ATT; ++rep_) phase_attention(a, l, lds, G, vcu);
#endif
        SEAM(pb + 3);
#if PHMASK & 32
        if (IN(pb + 4)) {
            { pg8::Gemm g{AO, Wout, MX, DM, DM, DM}; pg8::StaticOrder S; S.init(MX, DM, G, bx); pg8::EpiResid E{rX, rC, X, modl + 2 * DM, USE_XB ? H0 : nullptr};
              pg8::gemm_phase<pg8::EpiResid, pg8::StaticOrder, true, RES_SP2>((LAS unsigned char*)lds, g, S, E); }
            if (l == 0) {
              pg8::Gemm g{AO, Wout, MT, DM, DM, DM / 4}; pg8::SplitOrder S; S.init(MX / 256, MC / 256, DM / 256, 4, G, bx); pg8::EpiPart E{(float*)(ws + WS_STASH), MX / 256, (size_t)MC * DM};
              pg8::gemm_phase<pg8::EpiPart, pg8::SplitOrder, true, true>((LAS unsigned char*)lds, g, S, E); }
        }
#endif
        SEAM(pb + 4);
#if PHMASK & 64
        if (IN(pb + 5)) for (int rep_ = 0; rep_ < REP_NORM; ++rep_) phase_norm(X, l == 0 ? a.in[I_CTX] : X + (size_t)MX * DM, M2, a.in[I_GMLP] + l * DM, modl, 3, 4, H0, l == 0 ? (const float*)(ws + WS_STASH) : nullptr, (const float*)(ws + WS_MOD) + 8 * MODW + 2 * DM, l == 0 ? X + (size_t)MX * DM : nullptr, USE_XB != 0, G, vcu);
#endif
        SEAM(pb + 5);
#if PHMASK & 128
        if (IN(pb + 6)) for (int rep_ = 0; rep_ < REP_UP; ++rep_) { pg8::Gemm g{H0, Wup, M2, HID, DM, DM}; pg8::StaticOrder S; S.init(M2, HID, G, bx); pg8::EpiStore<1> E{HM, HIDP};
            pg8::gemm_phase<pg8::EpiStore<1>, pg8::StaticOrder, true, true>((LAS unsigned char*)lds, g, S, E); }
#endif
        SEAM(pb + 6);
#if PHMASK & 256
        if (IN(pb + 7)) {
            for (int rd_ = 0; rd_ < REP_DN; ++rd_) { pg8::Gemm g{HM, Wdn, MX, DM, HIDP, HID}; pg8::StaticOrder S; S.init(MX, DM, G, bx, DN_WGM); pg8::EpiResid E{X, X + (size_t)MX * DM, rd_ + 1 < REP_DN ? a.out : X, modl + 5 * DM, (USE_XB && l == 0) ? H0 : nullptr};
              pg8::gemm_phase<pg8::EpiResid, pg8::StaticOrder, true, RES_SP2>((LAS unsigned char*)lds, g, S, E); }
            if (l == 0) {
              pg8::Gemm g{HM, Wdn, MT, DM, HIDP, HID / 4}; pg8::SplitOrder S; S.init(MX / 256, MC / 256, DM / 256, 4, G, bx); pg8::EpiPart E{(float*)(ws + WS_STASH), MX / 256, (size_t)MC * DM};
              pg8::gemm_phase<pg8::EpiPart, pg8::SplitOrder, true, true>((LAS unsigned char*)lds, g, S, E); }
        }
#endif
        SEAM(pb + 7);
    }
#if PHMASK & 512
    if (IN(17)) phase_final((const float*)(ws + WS_X), a.in[I_GFIN], a.out, G, vcu);
#endif
#undef IN
#undef SEAM
}

extern "C" void kernel_launch(void* const* d_in, const int* in_sizes, int n_in, void* d_out, int out_size, void* d_ws, size_t ws_size, hipStream_t stream) {
    static int grid = 0;
    if (grid == 0) {
        if (n_in != 22 || out_size != MX * DM || ws_size < WS_END) { fprintf(stderr, "kernel_launch: unexpected shapes (n_in %d out %d ws %zu need %zu)\n", n_in, out_size, ws_size, (size_t)WS_END); grid = -1; return; }
        int dev = 0, cus = 0, per_cu = 0;
        hipGetDevice(&dev); hipDeviceGetAttribute(&cus, hipDeviceAttributeMultiprocessorCount, dev);
        if (hipFuncSetAttribute((const void*)fwd_kernel, hipFuncAttributeMaxDynamicSharedMemorySize, LDS_BYTES) != hipSuccess) { fprintf(stderr, "kernel_launch: hipFuncSetAttribute failed\n"); grid = -1; return; }
        if (hipOccupancyMaxActiveBlocksPerMultiprocessor(&per_cu, (const void*)fwd_kernel, NTHREADS, LDS_BYTES) != hipSuccess || per_cu < 1) { fprintf(stderr, "kernel_launch: occupancy query gave %d\n", per_cu); per_cu = 1; }
        (void)hipGetLastError();
        grid = cus * per_cu;
        fprintf(stderr, "kernel_launch: grid %d (cus %d x %d)\n", grid, cus, per_cu);
    }
    if (grid < 0) return;
    (void)hipMemsetAsync(d_ws, 0, 16384, stream);
    Args a{};
    for (int i = 0; i < 22; ++i) a.in[i] = (const float*)d_in[i];
    a.out = (float*)d_out; a.ws = (unsigned char*)d_ws;
#if MK_COOP
    a.ph_lo = 0; a.ph_hi = N_PHASES;
    void* args[] = {&a};
    hipError_t e = hipLaunchCooperativeKernel((const void*)fwd_kernel, dim3(grid), dim3(NTHREADS), args, LDS_BYTES, stream);
    if (e != hipSuccess) fprintf(stderr, "kernel_launch: cooperative launch failed: %s (grid %d)\n", hipGetErrorString(e), grid);
#else
    for (int ph = 0; ph < N_PHASES; ++ph) { a.ph_lo = ph; a.ph_hi = ph + 1; hipLaunchKernelGGL(fwd_kernel, dim3(grid), dim3(NTHREADS), LDS_BYTES, stream, a); }
#endif
}
```

```cpp
#include <hip/hip_runtime.h>
#include <hip/hip_cooperative_groups.h>
#include <cstdio>
#include <cstdint>
namespace cg = cooperative_groups;

constexpr int DM = 2048, NB = 8, SEQ = 2048, CTXL = 256, PW = 5120, HID = 8192, HIDP = HID + 64  , NMOD = 6, MODW = NMOD * DM;
constexpr int MX = NB * SEQ, MC = NB * CTXL, MT = MX + MC;
constexpr float NORM_EPS = 1e-6f;
constexpr int NWAVES = 8, NTHREADS = 512;
constexpr int LDS_BYTES = 147456;
constexpr size_t WIN_B = (size_t)PW * DM * 2, WOUT_B = (size_t)DM * DM * 2, WUP_B = (size_t)HID * DM * 2, WDN_B = (size_t)DM * HIDP * 2, WL_B = WIN_B + WOUT_B + WUP_B + WDN_B;
constexpr size_t WS_WT = 1u << 20;
constexpr size_t WS_MOD = WS_WT + 2 * WL_B;
constexpr size_t MOD_B = (size_t)2 * 9 * MODW * 4;
constexpr size_t WS_ROPE = WS_MOD + MOD_B;
constexpr size_t ROPE_B = (size_t)2048 * 64 * 4 * 2 + (size_t)2048 * 32 * 4 * 2;
constexpr size_t WS_X = WS_ROPE + ROPE_B;
constexpr size_t X_B = (size_t)MT * DM * 4;
constexpr size_t WS_H0 = WS_X + X_B;
constexpr size_t H0_B = (size_t)MT * DM * 2;
constexpr size_t WS_BIG = WS_H0 + H0_B;
constexpr size_t BIG_B = (size_t)MT * HIDP * 2;
constexpr size_t WS_P = WS_BIG, P_B = (size_t)MT * PW * 2;
constexpr size_t WS_AO = WS_P + P_B, AO_B = (size_t)MT * DM * 2;
static_assert(WS_AO + AO_B <= WS_BIG + BIG_B, "overlay");
constexpr size_t WS_STASH = WS_BIG + BIG_B, STASH_B = (size_t)256 * 2 * 256 * 128 * 4;
constexpr size_t WS_END = WS_STASH + STASH_B;
static_assert(WS_MOD % 256 == 0 && WS_ROPE % 256 == 0 && WS_X % 256 == 0 && WS_H0 % 256 == 0 && WS_BIG % 256 == 0 && WS_AO % 256 == 0 && WS_STASH % 256 == 0, "align");

typedef unsigned short bf16;
#define LAS __attribute__((address_space(3)))
__device__ __forceinline__ float bf2f(unsigned v) { return __builtin_bit_cast(float, v << 16); }
__device__ __forceinline__ unsigned f2bf(float f) { unsigned u = __builtin_bit_cast(unsigned, f); return (u + 0x7fffu + ((u >> 16) & 1u)) >> 16; }
__device__ __forceinline__ unsigned pk2(float lo, float hi) { return f2bf(lo) | (f2bf(hi) << 16); }
template <int K> __device__ __forceinline__ float sum_xor(float v) {
    if constexpr (K < 32) return v + __builtin_bit_cast(float, __builtin_amdgcn_ds_swizzle(__builtin_bit_cast(int, v), (K << 10) | 0x1f));
    else { const unsigned b = __builtin_bit_cast(unsigned, v); auto rr = __builtin_amdgcn_permlane32_swap(b, b, false, false); return __builtin_bit_cast(float, (unsigned)rr[0]) + __builtin_bit_cast(float, (unsigned)rr[1]); }
}
__device__ __forceinline__ float wave_sum(float v) {
    v = sum_xor<1>(v); v = sum_xor<2>(v); v = sum_xor<4>(v); v = sum_xor<8>(v); v = sum_xor<16>(v); v = sum_xor<32>(v);
    return v;
}
#define MK_COOP 1

#define XB_TMO      128
#define XB_XCNT(j)  (256  + 64 * (j))
#define XB_XSUB(j)  (1280 + 64 * (j))
#define XB_XGEN(j)  (2304 + 64 * (j))
#define XB_TOP      3328
#define XB_TOPGEN   3392
#define XCD_BAR_WORDS 3456
#define XB_SPIN_CAP (1u << 18)

__device__ __forceinline__ unsigned xb_ld(unsigned* p)              { return __hip_atomic_load(p, __ATOMIC_RELAXED, __HIP_MEMORY_SCOPE_AGENT); }
__device__ __forceinline__ unsigned xb_add(unsigned* p, unsigned v) { return __hip_atomic_fetch_add(p, v, __ATOMIC_RELAXED, __HIP_MEMORY_SCOPE_AGENT); }
__device__ __forceinline__ unsigned xb_xcc_id() { return (unsigned)__builtin_amdgcn_s_getreg((3 << 11) | 20) & 0xFu; }
#define XB_SPIN(cond, bar) do { unsigned _sp = 0; while (cond) { __builtin_amdgcn_s_sleep(1); \
    if ((++_sp & 255u) == 0u) { if (xb_ld(&(bar)[XB_TMO])) break; if (_sp > XB_SPIN_CAP) { atomicAdd(&(bar)[XB_TMO], 1u); break; } } } } while (0)

struct XcdBarrier {
    unsigned* bar; unsigned x;
    volatile LAS unsigned* st;
};

__device__ __forceinline__ XcdBarrier xcd_barrier_post(unsigned* bar, volatile LAS unsigned* st) {
    XcdBarrier b; b.bar = bar; b.x = xb_xcc_id(); b.st = st;
    if (threadIdx.x == 0) (void)xb_add(&bar[XB_XCNT(b.x)], 1u);
    return b;
}
__device__ __forceinline__ void xcd_barrier_complete(unsigned* bar, unsigned x, unsigned& nloc, unsigned& nx) {
    const unsigned G = gridDim.x * gridDim.y * gridDim.z;
    unsigned sum, cnt, mine, sp = 0u;
    for (;;) {
        sum = 0u; cnt = 0u; mine = 0u;
#pragma unroll
        for (unsigned j = 0; j < 16; ++j) { const unsigned c = xb_ld(&bar[XB_XCNT(j)]); sum += c; cnt += (c > 0u) ? 1u : 0u; mine = (j == x) ? c : mine; }
        if (sum == G) break;
        __builtin_amdgcn_s_sleep(1);
        if ((++sp & 255u) == 0u) { if (xb_ld(&bar[XB_TMO])) break; if (sp > XB_SPIN_CAP) { atomicAdd(&bar[XB_TMO], 1u); break; } }
    }
    nloc = mine > 0u ? mine : 1u; nx = cnt > 0u ? cnt : 1u;
}

__device__ __forceinline__ void xcd_barrier(const XcdBarrier& b) {
    asm volatile("s_waitcnt vmcnt(0)" ::: "memory");
    __syncthreads();
    if (threadIdx.x == 0) {
        unsigned* bar = b.bar;
        __builtin_amdgcn_s_waitcnt(0);
        unsigned nloc = b.st[0], nx = b.st[1];
        if (nloc == 0u) { xcd_barrier_complete(bar, b.x, nloc, nx); b.st[0] = nloc; b.st[1] = nx; }
        const unsigned old = xb_add(&bar[XB_XSUB(b.x)], 1u);
        const unsigned gen = old / nloc;
        if (old + 1u == (gen + 1u) * nloc) {
            __builtin_amdgcn_fence(__ATOMIC_RELEASE, "agent");
            asm volatile("s_waitcnt vmcnt(0)" ::: "memory");
            const unsigned og = xb_add(&bar[XB_TOP], 1u);
            const unsigned tg = og / nx;
            if (og + 1u == (tg + 1u) * nx) xb_add(&bar[XB_TOPGEN], 1u);
            else XB_SPIN(xb_ld(&bar[XB_TOPGEN]) == tg, bar);
            __builtin_amdgcn_fence(__ATOMIC_ACQUIRE, "agent");
            xb_add(&bar[XB_XGEN(b.x)], 1u);
            asm volatile("s_waitcnt vmcnt(0)" ::: "memory");
        } else {
            XB_SPIN(xb_ld(&bar[XB_XGEN(b.x)]) == gen, bar);
            __builtin_amdgcn_fence(__ATOMIC_ACQUIRE, "agent");
            asm volatile("s_waitcnt vmcnt(0)" ::: "memory");
        }
    }
    __syncthreads();
}
namespace pg8 {
#define PG8_LAS __attribute__((address_space(3)))
typedef unsigned short bf16_t;
typedef short bf16x8 __attribute__((ext_vector_type(8)));
typedef float f32x4 __attribute__((ext_vector_type(4)));
typedef unsigned u32x4 __attribute__((ext_vector_type(4)));
constexpr int BM = 256, BK = 64, HALF = 128, HTB = HALF * BK * 2  , STAGE_BYTES = 8 * HTB, NXCD = 8, WGM = 8;

__host__ __device__ __forceinline__ int lds_byte(int r, int c) { const int st = (r >> 4) * 2 + (c >> 5), rr = r & 15, cc = c & 31, ob = rr * 64 + cc * 2; return st * 1024 + (ob ^ (((ob >> 9) & 1) << 5)); }
__host__ __device__ __forceinline__ void stage_rc(int b, int& R, int& C) { const int st = b / 1024, sb = b % 1024, swz = sb ^ (((sb >> 9) & 1) << 5); R = (st >> 1) * 16 + swz / 64; C = (st & 1) * 32 + (swz % 64) / 2; }
__host__ __device__ __forceinline__ int perm32(int rho) { const int n = rho >> 4, i = rho & 15; return 8 * (i >> 2) + 4 * n + (i & 3); }

struct Unit { int pm, pn, ks; };
struct Gemm { const bf16_t* A; const bf16_t* Bt; int M, N, K, Kext; };

struct StaticOrder {
    int nM, nN, nwg, G, c, wgm;
    __host__ __device__ void init(int M, int N, int G_, int c_, int wgm_ = WGM) { nM = M / BM; nN = N / BM; nwg = nM * nN; G = G_; c = c_; wgm = wgm_; }
    __host__ __device__ bool next(int i, Unit& u) const {
        const long L = (long)i * G + c; if (L >= nwg) return false;
        int wgid = (int)L; { const int q = nwg / NXCD, r = nwg % NXCD, xcd = wgid % NXCD, off = wgid / NXCD; wgid = (xcd < r ? xcd * (q + 1) : r * (q + 1) + (xcd - r) * q) + off; }
        const int nig = wgm * nN, gid = wgid / nig, fm = gid * wgm, gsz = (nM - fm) < wgm ? (nM - fm) : wgm;
        u.pm = fm + ((wgid % nig) % gsz); u.pn = (wgid % nig) / gsz; u.ks = 0; return true;
    }
    __device__ __forceinline__ void a_ready(const Unit&) const {}
    __device__ __forceinline__ void done(const Unit&) const {}
};

__device__ __forceinline__ unsigned cvt_pk_bf16(float lo, float hi) { unsigned r; asm volatile("v_cvt_pk_bf16_f32 %0, %1, %2" : "=v"(r) : "v"(lo), "v"(hi)); return r; }
typedef float f32x2 __attribute__((ext_vector_type(2)));
#ifdef EPI_NT
#define EPI_ST(T, p, v) __builtin_nontemporal_store((v), (T*)(p))
#else
#define EPI_ST(T, p, v) (*(T*)(p) = (v))
#endif
template <int ACT> struct EpiStore {
    static constexpr bool PERM = true, AFTER_DRAIN = false;
    bf16_t* O; int ldc;
    __device__ __forceinline__ void operator()(const f32x4 (&acc)[2][2][4][2], const Unit& u, int wr, int wc, int fr, int fq) const {
        const int row0 = u.pm * BM + wr * 64 + fr; const int col0 = u.pn * BM + wc * 32 + 8 * fq;
#pragma unroll
        for (int ai = 0; ai < 2; ++ai)
#pragma unroll
            for (int m = 0; m < 4; ++m) { bf16_t* rowp = O + (size_t)(row0 + ai * HALF + m * 16) * ldc + col0;
#pragma unroll
                for (int bj = 0; bj < 2; ++bj) { f32x4 v0 = acc[ai][bj][m][0], v1 = acc[ai][bj][m][1];
                    if (ACT == 1) {
#pragma unroll
                        for (int e = 0; e < 4; ++e) { float a = fmaxf(v0[e], 0.f), b = fmaxf(v1[e], 0.f); v0[e] = a * a; v1[e] = b * b; } }
                    u32x4 w; w.x = cvt_pk_bf16(v0[0], v0[1]); w.y = cvt_pk_bf16(v0[2], v0[3]); w.z = cvt_pk_bf16(v1[0], v1[1]); w.w = cvt_pk_bf16(v1[2], v1[3]);
                    EPI_ST(u32x4, rowp + bj * HALF, w); } }
    }
};
struct EpiResid {
    static constexpr bool PERM = false, AFTER_DRAIN = false;
    const float* resX; const float* resC; float* out; const float* gate; bf16_t* xb;
    __device__ __forceinline__ void operator()(const f32x4 (&acc)[2][2][4][2], const Unit& u, int wr, int wc, int fr, int fq) const {
        const int batch = u.pm < 64 ? (u.pm >> 3) : 8;
        const float* res = u.pm < 64 ? resX + (size_t)u.pm * BM * 2048 : resC + (size_t)(u.pm - 64) * BM * 2048;
        float* o = out + (size_t)u.pm * BM * 2048;
        const int col0 = u.pn * BM + wc * 32 + 4 * fq;
        const float* gp = gate + (size_t)batch * 12288 + col0;
        f32x4 gv[2][2];
#pragma unroll
        for (int bj = 0; bj < 2; ++bj)
#pragma unroll
            for (int n = 0; n < 2; ++n) gv[bj][n] = *(const f32x4*)(gp + bj * HALF + n * 16);
#pragma unroll
        for (int ai = 0; ai < 2; ++ai)
#pragma unroll
          for (int mh = 0; mh < 2; ++mh) {
            f32x4 rv[2][2][2];
#pragma unroll
            for (int mm = 0; mm < 2; ++mm) { const int m = mh * 2 + mm; const size_t off = (size_t)(ai * HALF + wr * 64 + m * 16 + fr) * 2048 + col0;
#pragma unroll
                for (int bj = 0; bj < 2; ++bj)
#pragma unroll
                    for (int n = 0; n < 2; ++n) rv[mm][bj][n] = *(const f32x4*)(res + off + bj * HALF + n * 16); }
            __builtin_amdgcn_sched_barrier(0);
#pragma unroll
            for (int mm = 0; mm < 2; ++mm) { const int m = mh * 2 + mm; const size_t off = (size_t)(ai * HALF + wr * 64 + m * 16 + fr) * 2048 + col0;
#pragma unroll
                for (int bj = 0; bj < 2; ++bj)
#pragma unroll
                    for (int n = 0; n < 2; ++n) { const f32x4 y = rv[mm][bj][n] + gv[bj][n] * acc[ai][bj][m][n]; EPI_ST(f32x4, o + off + bj * HALF + n * 16, y);
                        if (xb) { typedef unsigned u32x2 __attribute__((ext_vector_type(2))); u32x2 w; w.x = cvt_pk_bf16(y[0], y[1]); w.y = cvt_pk_bf16(y[2], y[3]); *(u32x2*)(xb + (size_t)u.pm * BM * 2048 + off + bj * HALF + n * 16) = w; } } }
            __builtin_amdgcn_sched_barrier(0);
          }
    }
};

struct EpiPart {
    static constexpr bool PERM = false, AFTER_DRAIN = false;
    float* part; int pm0; size_t slice;
    __device__ __forceinline__ void operator()(const f32x4 (&acc)[2][2][4][2], const Unit& u, int wr, int wc, int fr, int fq) const {
        float* o = part + (size_t)u.ks * slice + (size_t)(u.pm - pm0) * BM * 2048;
        const int col0 = u.pn * BM + wc * 32 + 4 * fq;
#pragma unroll
        for (int ai = 0; ai < 2; ++ai)
#pragma unroll
            for (int m = 0; m < 4; ++m) { const size_t off = (size_t)(ai * HALF + wr * 64 + m * 16 + fr) * 2048 + col0;
#pragma unroll
                for (int bj = 0; bj < 2; ++bj)
#pragma unroll
                    for (int n = 0; n < 2; ++n) EPI_ST(f32x4, o + off + bj * HALF + n * 16, acc[ai][bj][m][n]); }
    }
};
struct SplitOrder {
    int pm0, nM, nN, NS, G, c;
    __host__ __device__ void init(int pm0_, int nM_, int nN_, int NS_, int G_, int c_) { pm0 = pm0_; nM = nM_; nN = nN_; NS = NS_; G = G_; c = c_; }
    __host__ __device__ bool next(int i, Unit& u) const {
        const long L = (long)i * G + c; if (L >= (long)nM * nN * NS) return false;
        const int t = (int)L / NS; u.ks = (int)L % NS; u.pm = pm0 + t % nM; u.pn = t / nM; return true;
    }
    __device__ __forceinline__ void a_ready(const Unit&) const {}
    __device__ __forceinline__ void done(const Unit&) const {}
};

struct EpiInProj {
    static constexpr bool PERM = true, AFTER_DRAIN = false;
    bf16_t* O; int ldc; const float* gq; const float* gk; const float* rope; PG8_LAS float* red;
    __device__ __forceinline__ void operator()(const f32x4 (&acc)[2][2][4][2], const Unit& u, int wr, int wc, int fr, int fq) const {
        const int pn = u.pn; const bool lat = u.pm < 64;
        const int kind = pn <= 2 ? 1 : ((pn >= 10 && pn <= 13) ? 2 : ((pn >= 16 && pn <= 18) ? 3 : 0));
        const int row0 = u.pm * BM + wr * 64 + fr; const int col0 = pn * BM + wc * 32 + 8 * fq;
        const bool do_rope = lat && kind != 0;
        f32x4 g0 = (f32x4){1.f, 1.f, 1.f, 1.f}, g1 = g0;
        if (kind == 1) {
            const float* gp = (pn < 2 ? gq : gk) + wc * 32 + 8 * fq; g0 = *(const f32x4*)gp; g1 = *(const f32x4*)(gp + 4);
#pragma unroll
            for (int ai = 0; ai < 2; ++ai)
#pragma unroll
                for (int m = 0; m < 4; ++m)
#pragma unroll
                    for (int bj = 0; bj < 2; ++bj) { const f32x4 a = acc[ai][bj][m][0], b = acc[ai][bj][m][1];
                        float s = (a[0] * a[0] + a[1] * a[1]) + (a[2] * a[2] + a[3] * a[3]) + (b[0] * b[0] + b[1] * b[1]) + (b[2] * b[2] + b[3] * b[3]);
                        s = ::sum_xor<16>(s); s = ::sum_xor<32>(s);
                        if (fq == 0) red[((ai * HALF + wr * 64 + m * 16 + fr) * 2 + bj) * 4 + wc] = s; }
            asm volatile("s_waitcnt lgkmcnt(0)" ::: "memory"); __builtin_amdgcn_s_barrier(); asm volatile("" ::: "memory");
        }
        const float* cosT = rope; const float* sinT = rope + 2048 * 64; int tw = 64, p0 = wc * 16 + 4 * fq;
        if (kind == 2) { cosT = rope + 2 * 2048 * 64; sinT = cosT + 2048 * 32; tw = 32; p0 = (wc & 1) * 16 + 4 * fq; }
        f32x4 csa[2][4], sna[2][4];
#pragma unroll
        for (int ai = 0; ai < 2; ++ai)
#pragma unroll
            for (int m = 0; m < 4; ++m) { csa[ai][m] = (f32x4){1.f, 1.f, 1.f, 1.f}; sna[ai][m] = (f32x4){0.f, 0.f, 0.f, 0.f};
                if (do_rope) { const int pos = (row0 + ai * HALF + m * 16) & 2047; csa[ai][m] = *(const f32x4*)(cosT + pos * tw + p0); sna[ai][m] = *(const f32x4*)(sinT + pos * tw + p0); } }
        __builtin_amdgcn_sched_barrier(0);
#pragma unroll
        for (int ai = 0; ai < 2; ++ai)
#pragma unroll
            for (int m = 0; m < 4; ++m) { const int row = row0 + ai * HALF + m * 16; bf16_t* rowp = O + ((size_t)(pn * 2) * ldc + row) * 128 + wc * 32 + 8 * fq;
                const f32x4 cs = csa[ai][m], sn = sna[ai][m];
#pragma unroll
                for (int bj = 0; bj < 2; ++bj) { f32x4 v0 = acc[ai][bj][m][0], v1 = acc[ai][bj][m][1];
                    if (kind == 1) { const f32x4 t = *(const PG8_LAS f32x4*)(red + ((ai * HALF + wr * 64 + m * 16 + fr) * 2 + bj) * 4);
                        const float r = 1.0f / sqrtf(((t[0] + t[1]) + (t[2] + t[3])) * (1.0f / 128.0f) + 1e-6f); v0 = v0 * r * g0; v1 = v1 * r * g1; }
                    if (kind != 0) { const f32x4 a = v0, b = v1;
                        v0[0] = a[0] * cs[0] - a[1] * sn[0]; v0[1] = a[0] * sn[0] + a[1] * cs[0]; v0[2] = a[2] * cs[1] - a[3] * sn[1]; v0[3] = a[2] * sn[1] + a[3] * cs[1];
                        v1[0] = b[0] * cs[2] - b[1] * sn[2]; v1[1] = b[0] * sn[2] + b[1] * cs[2]; v1[2] = b[2] * cs[3] - b[3] * sn[3]; v1[3] = b[2] * sn[3] + b[3] * cs[3]; }
                    u32x4 w; w.x = cvt_pk_bf16(v0[0], v0[1]); w.y = cvt_pk_bf16(v0[2], v0[3]); w.z = cvt_pk_bf16(v1[0], v1[1]); w.w = cvt_pk_bf16(v1[2], v1[3]);
                    EPI_ST(u32x4, rowp + (size_t)bj * ldc * 128, w); } }
    }
};

struct ChunkOrder {
    StaticOrder S; int nr, nch;
    __host__ __device__ void init(int M, int N, int G_, int c_, int wgm_, int nch_) { S.init(M, N, G_, c_, wgm_); nr = (S.nwg + G_ - 1) / G_; nch = nch_; }
    __host__ __device__ bool next(int i, Unit& u) const { const int ch = i / nr; if (ch >= nch) return false; const bool ok = S.next(i - ch * nr, u); u.ks = ch; return ok; }
    __device__ __forceinline__ void a_ready(const Unit&) const {}
    __device__ __forceinline__ void done(const Unit&) const {}
};

template <bool RES_F32> struct EpiResidB {
    static constexpr bool PERM = true, AFTER_DRAIN = false;
    const float* resf; const bf16_t* resh; bf16_t* out; const float* gate;
    __device__ __forceinline__ void operator()(const f32x4 (&acc)[2][2][4][2], const Unit& u, int wr, int wc, int fr, int fq) const {
        const int batch = u.pm >> 3;
        int rl = wr * 64 + fr; asm volatile("" : "+v"(rl));
        const size_t rbase = (size_t)u.pm * BM * 2048;
        bf16_t* o = out + (size_t)u.pm * BM * 2048;
        const int col0 = u.pn * BM + wc * 32 + 8 * fq;
        const float* gp = gate + (size_t)batch * 12288 + col0;
        f32x4 gv[2][2];
#pragma unroll
        for (int bj = 0; bj < 2; ++bj)
#pragma unroll
            for (int n = 0; n < 2; ++n) gv[bj][n] = *(const f32x4*)(gp + bj * HALF + 4 * n);
        constexpr int NB = RES_F32 ? 1 : 2;
#pragma unroll
        for (int ai = 0; ai < 2; ++ai)
#pragma unroll
          for (int mbi = 0; mbi < 4 / NB; ++mbi) { const int mb = mbi * NB;
            f32x4 rf[NB][2][2]; u32x4 rw[NB][2];
#pragma unroll
            for (int mm = 0; mm < NB; ++mm) { const int m = mb + mm; const size_t off = (size_t)(ai * HALF + m * 16 + rl) * 2048 + col0;
#pragma unroll
                for (int bj = 0; bj < 2; ++bj) {
                    if constexpr (RES_F32) { const float* rp = resf + rbase + off + bj * HALF; rf[mm][bj][0] = *(const f32x4*)rp; rf[mm][bj][1] = *(const f32x4*)(rp + 4); }
                    else rw[mm][bj] = *(const u32x4*)(resh + rbase + off + bj * HALF); } }
            __builtin_amdgcn_sched_barrier(0);
#pragma unroll
            for (int mm = 0; mm < NB; ++mm) { const int m = mb + mm; const size_t off = (size_t)(ai * HALF + m * 16 + rl) * 2048 + col0;
#pragma unroll
                for (int bj = 0; bj < 2; ++bj) { f32x4 r0, r1;
                    if constexpr (RES_F32) { r0 = rf[mm][bj][0]; r1 = rf[mm][bj][1]; }
                    else { const u32x4 w = rw[mm][bj];
                        r0 = (f32x4){__builtin_bit_cast(float, w.x << 16), __builtin_bit_cast(float, w.x & 0xffff0000u), __builtin_bit_cast(float, w.y << 16), __builtin_bit_cast(float, w.y & 0xffff0000u)};
                        r1 = (f32x4){__builtin_bit_cast(float, w.z << 16), __builtin_bit_cast(float, w.z & 0xffff0000u), __builtin_bit_cast(float, w.w << 16), __builtin_bit_cast(float, w.w & 0xffff0000u)}; }
                    const f32x4 y0 = r0 + gv[bj][0] * acc[ai][bj][m][0], y1 = r1 + gv[bj][1] * acc[ai][bj][m][1];
                    u32x4 w2; w2.x = cvt_pk_bf16(y0[0], y0[1]); w2.y = cvt_pk_bf16(y0[2], y0[3]); w2.z = cvt_pk_bf16(y1[0], y1[1]); w2.w = cvt_pk_bf16(y1[2], y1[3]);
                    EPI_ST(u32x4, o + off + bj * HALF, w2); } }
            __builtin_amdgcn_sched_barrier(0);
          }
    }
};
template <class Epi, class Sched, bool ALIGN_EPI = false, bool SP2 = false>
__device__ __forceinline__ void gemm_phase(PG8_LAS unsigned char* lds, const Gemm g, const Sched& S, const Epi& E) {
    int tid_ = threadIdx.x; asm volatile("" : "+v"(tid_));
    const int tid = tid_, wid = __builtin_amdgcn_readfirstlane(tid >> 6), lane = tid & 63, wr = wid >> 2, wc = wid & 3, fr = lane & 15, fq = lane >> 4;
    const int K = g.K, nt = g.Kext / BK; const size_t sstep = (size_t)g.Kext * 2;
    unsigned voffA[2], voffB[2];
#pragma unroll
    for (int i = 0; i < 2; ++i) { int R, C; stage_rc(tid * 16 + i * 8192, R, C); const int Rb = Epi::PERM ? ((R & ~31) + perm32(R & 31)) : R;
        voffA[i] = (unsigned)(R * K + C) * 2u; voffB[i] = (unsigned)(Rb * K + C) * 2u; }
    const size_t kstep = (size_t)(BK * 2);
    const size_t hstep = (size_t)HALF * K * 2;
    const size_t tstep = 2 * hstep;
    const unsigned ldsw = (unsigned)wid * 1024u;
    const int aoff = lds_byte(wr * 64 + fr, fq * 8), boff = lds_byte(wc * 32 + fr, fq * 8);
#define PG8_SA(b, h) (((b) * 2 + (h)) * HTB)
#define PG8_SB(b, h) ((4 + (b) * 2 + (h)) * HTB)
#define PG8_STAGE(bufoff, gbase, voff) do { _Pragma("unroll") for (int _i = 0; _i < 2; ++_i) \
        __builtin_amdgcn_global_load_lds((const unsigned*)((const char*)(gbase) + (voff)[_i]), (PG8_LAS unsigned*)(lds + (bufoff) + ldsw + _i * 8192), 16, 0, 0); } while (0)
#define PG8_LDA(dst, b, h) do { _Pragma("unroll") for (int m = 0; m < 4; ++m) _Pragma("unroll") for (int k = 0; k < 2; ++k) dst[m][k] = *(const PG8_LAS bf16x8*)(lds + PG8_SA(b, h) + aoff + m * 2048 + k * 1024); } while (0)
#define PG8_LDB(dst, b, h) do { _Pragma("unroll") for (int n = 0; n < 2; ++n) _Pragma("unroll") for (int k = 0; k < 2; ++k) dst[n][k] = *(const PG8_LAS bf16x8*)(lds + PG8_SB(b, h) + boff + n * 2048 + k * 1024); } while (0)
#define PG8_MMA(ai, bj, At, Bt) do { __builtin_amdgcn_s_setprio(1); _Pragma("unroll") for (int m = 0; m < 4; ++m) _Pragma("unroll") for (int n = 0; n < 2; ++n) _Pragma("unroll") for (int k = 0; k < 2; ++k) \
        acc[ai][bj][m][n] = __builtin_amdgcn_mfma_f32_16x16x32_bf16(Bt[n][k], At[m][k], acc[ai][bj][m][n], 0, 0, 0); __builtin_amdgcn_s_setprio(0); } while (0)
#define PG8_WAIT_V(n) asm volatile("s_waitcnt vmcnt(" #n ")" ::: "memory")
#define PG8_WAIT_L(n) asm volatile("s_waitcnt lgkmcnt(" #n ")" ::: "memory")
#define PG8_BAR __builtin_amdgcn_s_barrier()
#define PG8_SCHED __builtin_amdgcn_sched_barrier(0)
    Unit cur, nxt; int ui = 0;
    if (!S.next(0, cur)) return;
    f32x4 acc[2][2][4][2];
#pragma unroll
    for (int a = 0; a < 2; ++a)
#pragma unroll
        for (int b = 0; b < 2; ++b)
#pragma unroll
            for (int m = 0; m < 4; ++m)
#pragma unroll
                for (int n = 0; n < 2; ++n) acc[a][b][m][n] = (f32x4){0.f, 0.f, 0.f, 0.f};
    bf16x8 At[4][2], B0[2][2], B1[2][2];
    const char* cA = (const char*)g.A + (size_t)cur.pm * tstep + (size_t)cur.ks * sstep; const char* cB = (const char*)g.Bt + (size_t)cur.pn * tstep + (size_t)cur.ks * sstep;
    S.a_ready(cur);
    if constexpr (SP2) {
        PG8_STAGE(PG8_SB(0, 0), cB, voffB); PG8_STAGE(PG8_SB(0, 1), cB + hstep, voffB); PG8_STAGE(PG8_SA(0, 0), cA, voffA); PG8_STAGE(PG8_SA(0, 1), cA + hstep, voffA);
        if (wr == 1) PG8_BAR;
        PG8_WAIT_V(2); PG8_BAR;
        PG8_STAGE(PG8_SB(1, 0), cB + kstep, voffB); PG8_STAGE(PG8_SA(1, 0), cA + kstep, voffA); PG8_STAGE(PG8_SB(1, 1), cB + hstep + kstep, voffB);
        PG8_WAIT_V(6); PG8_BAR;
    } else {
        PG8_STAGE(PG8_SB(0, 0), cB, voffB); PG8_STAGE(PG8_SA(0, 0), cA, voffA); PG8_STAGE(PG8_SB(0, 1), cB + hstep, voffB); PG8_STAGE(PG8_SA(0, 1), cA + hstep, voffA);
        if (wr == 1) PG8_BAR;
        PG8_WAIT_V(4); PG8_BAR;
        PG8_STAGE(PG8_SB(1, 0), cB + kstep, voffB); PG8_STAGE(PG8_SA(1, 0), cA + kstep, voffA); PG8_STAGE(PG8_SB(1, 1), cB + hstep + kstep, voffB);
        PG8_WAIT_V(6); PG8_BAR;
    }
    for (;;) {
        const bool has_next = S.next(ui + 1, nxt);
        const char* nA = has_next ? (const char*)g.A + (size_t)nxt.pm * tstep + (size_t)nxt.ks * sstep : cA; const char* nB = has_next ? (const char*)g.Bt + (size_t)nxt.pn * tstep + (size_t)nxt.ks * sstep : cB;
        for (int t = 0; t < nt; t += 2) {
            const bool last = (t == nt - 2);
            const char* a1 = cA + (size_t)(t + 1) * kstep;
            const char* a2 = last ? nA : cA + (size_t)(t + 2) * kstep; const char* b2 = last ? nB : cB + (size_t)(t + 2) * kstep;
            const char* a3 = a2 + kstep; const char* b3 = b2 + kstep;
            if (last && has_next) S.a_ready(nxt);
            if constexpr (SP2) {
            PG8_LDB(B0, 0, 0); PG8_LDB(B1, 0, 1); PG8_SCHED; PG8_LDA(At, 0, 0); PG8_STAGE(PG8_SA(1, 1), a1 + hstep, voffA);
            PG8_WAIT_V(8); PG8_WAIT_L(0); PG8_BAR; PG8_MMA(0, 0, At, B0); PG8_MMA(0, 1, At, B1); PG8_BAR; PG8_SCHED;
            PG8_LDA(At, 0, 1); PG8_STAGE(PG8_SB(0, 0), b2, voffB); PG8_STAGE(PG8_SB(0, 1), b2 + hstep, voffB); PG8_STAGE(PG8_SA(0, 0), a2, voffA);
            PG8_WAIT_V(8); PG8_WAIT_L(0); PG8_BAR; PG8_MMA(1, 0, At, B0); PG8_MMA(1, 1, At, B1); PG8_BAR; PG8_SCHED;
            PG8_LDB(B0, 1, 0); PG8_LDB(B1, 1, 1); PG8_SCHED; PG8_LDA(At, 1, 0); PG8_STAGE(PG8_SA(0, 1), a2 + hstep, voffA);
            PG8_WAIT_V(8); PG8_WAIT_L(0); PG8_BAR; PG8_MMA(0, 0, At, B0); PG8_MMA(0, 1, At, B1); PG8_BAR; PG8_SCHED;
            PG8_LDA(At, 1, 1); PG8_STAGE(PG8_SB(1, 0), b3, voffB); PG8_STAGE(PG8_SB(1, 1), b3 + hstep, voffB); PG8_STAGE(PG8_SA(1, 0), a3, voffA);
            PG8_WAIT_V(8); PG8_WAIT_L(0); PG8_BAR; PG8_MMA(1, 0, At, B0); PG8_MMA(1, 1, At, B1); PG8_BAR; PG8_SCHED;
            } else {
            PG8_LDB(B0, 0, 0); PG8_SCHED; PG8_LDA(At, 0, 0); PG8_STAGE(PG8_SA(1, 1), a1 + hstep, voffA);
            PG8_WAIT_L(8); PG8_BAR; PG8_WAIT_L(0); PG8_MMA(0, 0, At, B0); PG8_BAR; PG8_SCHED;
            PG8_LDB(B1, 0, 1); PG8_STAGE(PG8_SB(0, 0), b2, voffB);
            PG8_BAR; PG8_WAIT_L(0); PG8_MMA(0, 1, At, B1); PG8_BAR;
            PG8_LDA(At, 0, 1); PG8_STAGE(PG8_SA(0, 0), a2, voffA);
            PG8_BAR; PG8_WAIT_L(0); PG8_MMA(1, 0, At, B0); PG8_BAR; PG8_SCHED;
            PG8_STAGE(PG8_SB(0, 1), b2 + hstep, voffB);
            PG8_WAIT_V(6); PG8_BAR; PG8_MMA(1, 1, At, B1); PG8_BAR;
            PG8_LDB(B0, 1, 0); PG8_SCHED; PG8_LDA(At, 1, 0); PG8_STAGE(PG8_SA(0, 1), a2 + hstep, voffA);
            PG8_WAIT_L(8); PG8_BAR; PG8_WAIT_L(0); PG8_MMA(0, 0, At, B0); PG8_BAR; PG8_SCHED;
            PG8_LDB(B1, 1, 1); PG8_STAGE(PG8_SB(1, 0), b3, voffB);
            PG8_BAR; PG8_WAIT_L(0); PG8_MMA(0, 1, At, B1); PG8_BAR;
            PG8_LDA(At, 1, 1); PG8_STAGE(PG8_SA(1, 0), a3, voffA);
            PG8_BAR; PG8_WAIT_L(0); PG8_MMA(1, 0, At, B0); PG8_BAR; PG8_SCHED;
            PG8_STAGE(PG8_SB(1, 1), b3 + hstep, voffB);
            PG8_WAIT_V(6); PG8_BAR; PG8_MMA(1, 1, At, B1); PG8_BAR;
            }
        }
        if constexpr (ALIGN_EPI) { if (wr == 0) PG8_BAR; }
        if constexpr (!Epi::AFTER_DRAIN) { E(acc, cur, wr, wc, fr, fq); S.done(cur); }
        if (!has_next) break;
#pragma unroll
        for (int a = 0; a < 2; ++a)
#pragma unroll
            for (int b = 0; b < 2; ++b)
#pragma unroll
                for (int m = 0; m < 4; ++m)
#pragma unroll
                    for (int n = 0; n < 2; ++n) acc[a][b][m][n] = (f32x4){0.f, 0.f, 0.f, 0.f};
        cur = nxt; cA = nA; cB = nB; ++ui;
        if constexpr (ALIGN_EPI) { if (wr == 1) PG8_BAR; }
    }
    PG8_WAIT_V(0);
    if constexpr (!ALIGN_EPI) { if (wr == 0) PG8_BAR; }
    PG8_BAR;
    if constexpr (Epi::AFTER_DRAIN) { E.fused(acc, cur, wr, wc, fr, fq, lds, wid, lane); S.done(cur); }
#undef PG8_SA
#undef PG8_SB
#undef PG8_STAGE
#undef PG8_LDA
#undef PG8_LDB
#undef PG8_MMA
#undef PG8_WAIT_V
#undef PG8_WAIT_L
#undef PG8_BAR
#undef PG8_SCHED
}
}
namespace att {
constexpr int NW_ = 8, QBLK = 32;
using bf16x8 = __attribute__((ext_vector_type(8))) short;
using s16x4  = __attribute__((ext_vector_type(4))) short;
using f32x16 = __attribute__((ext_vector_type(16))) float;
using f32x8  = __attribute__((ext_vector_type(8))) float;
using u32x4  = __attribute__((ext_vector_type(4))) unsigned;
#define KSWZ(row, colB) ((row) * 256 + ((colB) ^ (((row) & 7) << 4)))
#define SBAR() __builtin_amdgcn_sched_barrier(0)
__device__ __forceinline__ int crow(int r, int hi) { return (r & 3) + 8 * (r >> 2) + 4 * hi; }
__device__ __forceinline__ unsigned cvtpk(float lo, float hi) {
  unsigned r; asm volatile("v_cvt_pk_bf16_f32 %0, %1, %2" : "=v"(r) : "v"(lo), "v"(hi)); return r;
}
template <typename TIn> struct Stage;
template <> struct Stage<bf16>  { using T = bf16x8;
  __device__ static __forceinline__ T ld8(const bf16* p) { return *reinterpret_cast<const bf16x8*>(p); }
  __device__ static __forceinline__ bf16x8 tobf(T x) { return x; } };
template <> struct Stage<float> { using T = f32x8;
  __device__ static __forceinline__ T ld8(const float* p) { return *reinterpret_cast<const f32x8*>(p); }
  __device__ static __forceinline__ bf16x8 tobf(T x) {
    u32x4 w = {cvtpk(x[0], x[1]), cvtpk(x[2], x[3]), cvtpk(x[4], x[5]), cvtpk(x[6], x[7])}; return *reinterpret_cast<bf16x8*>(&w); } };

__device__ __forceinline__ void partialSM(f32x16& p0, f32x16& p1, float& m_reg, float& mn, float& alpha, const float C, const float thr_raw) {
  float pmax = p0[0]; for (int r = 1; r < 16; ++r) pmax = fmaxf(pmax, p0[r]); for (int r = 0; r < 16; ++r) pmax = fmaxf(pmax, p1[r]);
  { auto rr = __builtin_amdgcn_permlane32_swap(__float_as_uint(pmax), __float_as_uint(pmax), false, false);
    pmax = fmaxf(__uint_as_float(rr[0]), __uint_as_float(rr[1])); }
  if (__builtin_expect(__all(pmax - m_reg <= thr_raw), 1)) { mn = m_reg; alpha = 1.f; }
  else { mn = fmaxf(m_reg, pmax); alpha = __builtin_amdgcn_exp2f((m_reg - mn) * C); m_reg = mn; }
  float mnC = -mn * C;
  for (int r = 0; r < 16; ++r) p0[r] = fmaf(p0[r], C, mnC); for (int r = 0; r < 16; ++r) p1[r] = fmaf(p1[r], C, mnC);
  for (int r = 0; r < 16; ++r) p0[r] = __builtin_amdgcn_exp2f(p0[r]);
}
__device__ __forceinline__ void finishSM(f32x16& p0, f32x16& p1, float alpha, float& l_reg, bf16x8& pa0, bf16x8& pa1, bf16x8& pa2, bf16x8& pa3) {
  for (int r = 0; r < 16; ++r) p1[r] = __builtin_amdgcn_exp2f(p1[r]);
  float ps = 0; for (int r = 0; r < 16; ++r) ps += p0[r]; for (int r = 0; r < 16; ++r) ps += p1[r];
  { auto rr = __builtin_amdgcn_permlane32_swap(__float_as_uint(ps), __float_as_uint(ps), false, false);
    ps = __uint_as_float(rr[0]) + __uint_as_float(rr[1]); }
  l_reg = l_reg * alpha + ps;
#define PK4(P, BASE, OUT) do { unsigned a0 = cvtpk(P[BASE + 0], P[BASE + 1]), a1 = cvtpk(P[BASE + 2], P[BASE + 3]);   \
    unsigned b0 = cvtpk(P[BASE + 4], P[BASE + 5]), b1 = cvtpk(P[BASE + 6], P[BASE + 7]);                              \
    auto r0 = __builtin_amdgcn_permlane32_swap(a0, b0, false, false); auto r1 = __builtin_amdgcn_permlane32_swap(a1, b1, false, false); \
    u32x4 w = {r0[0], r1[0], r0[1], r1[1]}; OUT = *reinterpret_cast<bf16x8*>(&w); } while (0)
  PK4(p0, 0, pa0); PK4(p0, 8, pa1); PK4(p1, 0, pa2); PK4(p1, 8, pa3);
#undef PK4
}
template <bool full> __device__ __forceinline__ void qkt(f32x16& p0, f32x16& p1, const bf16* Ks, const bf16x8* qr, int r32, int hi, const int koff) {
  p0 = f32x16{}; p1 = f32x16{};
  for (int d0 = 0; d0 < 4; ++d0) { int cb = (d0 * 16 + hi * 8) * 2 + koff;
    bf16x8 b0 = *reinterpret_cast<const bf16x8*>((const char*)Ks + KSWZ(r32, cb));
    bf16x8 b1 = *reinterpret_cast<const bf16x8*>((const char*)Ks + KSWZ(32 + r32, cb));
    p0 = __builtin_amdgcn_mfma_f32_32x32x16_bf16(b0, qr[d0], p0, 0, 0, 0);
    p1 = __builtin_amdgcn_mfma_f32_32x32x16_bf16(b1, qr[d0], p1, 0, 0, 0); }
  if constexpr (full) {
  for (int d0 = 4; d0 < 8; ++d0) { int cb = (d0 * 16 + hi * 8) * 2;
    bf16x8 b0 = *reinterpret_cast<const bf16x8*>((const char*)Ks + KSWZ(r32, cb));
    bf16x8 b1 = *reinterpret_cast<const bf16x8*>((const char*)Ks + KSWZ(32 + r32, cb));
    p0 = __builtin_amdgcn_mfma_f32_32x32x16_bf16(b0, qr[d0], p0, 0, 0, 0);
    p1 = __builtin_amdgcn_mfma_f32_32x32x16_bf16(b1, qr[d0], p1, 0, 0, 0); } }
}
__device__ __forceinline__ int v_st(int k, int c) { const int kk = (k & ~0xC) | ((k & 4) << 1) | ((k & 8) >> 1); return ((kk >> 3) * 4 + (c >> 5)) * 512 + ((kk & 7) * 32 + (c & 31)) * 2; }
__device__ __forceinline__ int v_rd_base(int lane) { return ((lane & 3) << 3) | (((lane >> 2) & 3) << 6) | (((lane >> 4) & 1) << 5) | (((lane >> 5) & 1) << 8); }
constexpr int v_rd_off(int d0, int ks, int half) { return d0 * 512 + ks * 4096 + half * 2048; }
template <int OFF> __device__ __forceinline__ s16x4 tr_read(int vb) {
  s16x4 r; asm volatile("ds_read_b64_tr_b16 %0, %1 offset:%2" : "=&v"(r) : "v"(vb), "i"(OFF) : "memory"); return r;
}
template <int D0> __device__ __forceinline__ void pv_one(f32x16& od, int vb, bf16x8 pa0, bf16x8 pa1, bf16x8 pa2, bf16x8 pa3) {
  const s16x4 l0 = tr_read<v_rd_off(D0, 0, 0)>(vb), h0 = tr_read<v_rd_off(D0, 0, 1)>(vb), l1 = tr_read<v_rd_off(D0, 1, 0)>(vb), h1 = tr_read<v_rd_off(D0, 1, 1)>(vb);
  const s16x4 l2 = tr_read<v_rd_off(D0, 2, 0)>(vb), h2 = tr_read<v_rd_off(D0, 2, 1)>(vb), l3 = tr_read<v_rd_off(D0, 3, 0)>(vb), h3 = tr_read<v_rd_off(D0, 3, 1)>(vb);
  asm volatile("s_waitcnt lgkmcnt(0)" ::: "memory"); SBAR();
#define PK(L, H) (bf16x8){L[0], L[1], L[2], L[3], H[0], H[1], H[2], H[3]}
  od = __builtin_amdgcn_mfma_f32_32x32x16_bf16(pa0, PK(l0, h0), od, 0, 0, 0);
  od = __builtin_amdgcn_mfma_f32_32x32x16_bf16(pa1, PK(l1, h1), od, 0, 0, 0);
  od = __builtin_amdgcn_mfma_f32_32x32x16_bf16(pa2, PK(l2, h2), od, 0, 0, 0);
  od = __builtin_amdgcn_mfma_f32_32x32x16_bf16(pa3, PK(l3, h3), od, 0, 0, 0);
#undef PK
}
__device__ __forceinline__ void pv_d0(f32x16* o, int vb, bf16x8 pa0, bf16x8 pa1, bf16x8 pa2, bf16x8 pa3) {
  pv_one<0>(o[0], vb, pa0, pa1, pa2, pa3); pv_one<1>(o[1], vb, pa0, pa1, pa2, pa3); pv_one<2>(o[2], vb, pa0, pa1, pa2, pa3); pv_one<3>(o[3], vb, pa0, pa1, pa2, pa3);
}
struct AttnUnit {
  const bf16* Q; const bf16* K; const bf16* V; bf16* O;
  int ctx_row0, lat_row0, nctx, nt;
  int qpos0, kpos0;
  float C, thr_raw;
  int nsub, sub;
  float lam, post;
  const float* gsub;
  float sink; int has_sink;
  const float* rpb;
  float* stash;
};
#ifndef B_PIPE
#define B_PIPE 0
#endif
#ifndef ATT_SDEPTH
#define ATT_SDEPTH 1
#endif
#ifndef ATT_SDEPTH_FULL
#define ATT_SDEPTH_FULL 1
#endif
#ifndef ATT_SDEPTH_HALF
#define ATT_SDEPTH_HALF 2
#endif
constexpr int LDK = 128, LDO = 2048;
constexpr int SHM_V = 16384, SHM_K = 16384;
constexpr int ATT_WS_OFF = 2 * SHM_V + 2 * SHM_K, ATT_RPB_OFF = ATT_WS_OFF + NW_ * 64 * 4, ATT_LDS = ATT_RPB_OFF + 2048;

template <int MODE>
__device__ __forceinline__ void mask_tile(f32x16& p0, f32x16& p1, int j, const AttnUnit& u, int wid, int r32, int hi, const float* rpbL) {
  if (MODE == 0) return;
  if (j < u.nctx) return;
  int qi = u.qpos0 + wid * 32 + r32; asm volatile("" : "+v"(qi));
  if (MODE == 2) {
    const int kb = u.kpos0 + (j - u.nctx) * 64 + 4 * hi - qi;
#pragma unroll
    for (int r = 0; r < 16; ++r) { const int d0 = kb + (r & 3) + 8 * (r >> 2), d1 = d0 + 32;
      p0[r] = (d0 <= 128 && d0 >= -128) ? p0[r] : -1e30f; p1[r] = (d1 <= 128 && d1 >= -128) ? p1[r] : -1e30f; }
  } else {
    const int i = (u.kpos0 >> 6) + (j - u.nctx);
    const int qr_ = qi >> 6, qc = qi & 63;
    int rs = qr_ - 4; rs = rs < 0 ? 0 : (rs > 24 ? 24 : rs);
    int cs = qc - 8; cs = cs < 0 ? 0 : (cs > 48 ? 48 : cs);
    const bool rowok = (i >= rs) && (i < rs + 8);
    const int bbase = (i - qr_ + 7) * 31 + 15 - qc;
#pragma unroll
    for (int r = 0; r < 16; ++r) { const int c0 = (r & 3) + 8 * (r >> 2) + 4 * hi, c1 = c0 + 32;
        const bool ok0 = rowok && (unsigned)(c0 - cs) < 16u, ok1 = rowok && (unsigned)(c1 - cs) < 16u;
        const float b0 = rpbL[ok0 ? bbase + c0 : 0], b1 = rpbL[ok1 ? bbase + c1 : 0];
        p0[r] = ok0 ? p0[r] + b0 : -1e30f; p1[r] = ok1 ? p1[r] + b1 : -1e30f;
        if (r & 1) __builtin_amdgcn_sched_barrier(0); }
  }
}

#ifdef USE_SGB
#define SGB_QK() do { _Pragma("unroll") for (int i_ = 0; i_ < (FULL ? 16 : 8); ++i_) { __builtin_amdgcn_sched_group_barrier(0x008, 1, 0); __builtin_amdgcn_sched_group_barrier(0x100, 1, 0); __builtin_amdgcn_sched_group_barrier(0x002, SGB_NV, 0); } } while (0)
#else
#define SGB_QK() do { } while (0)
#endif
#ifndef SGB_NV
#define SGB_NV 6
#endif
template <int MODE, bool FULL>
__device__ __forceinline__ void attn_unit(const AttnUnit& u, char* lds) {
  using St = Stage<bf16>;
  constexpr int SDEPTH = (MODE == 0) ? (FULL ? ATT_SDEPTH_FULL : ATT_SDEPTH_HALF) : ATT_SDEPTH;
  int tid = threadIdx.x; asm volatile("" : "+v"(tid));
  const int wid = tid >> 6, lane = tid & 63, r32 = lane & 31, hi = lane >> 5;
  bf16* V_lds = (bf16*)lds; bf16* K_lds = (bf16*)(lds + 2 * SHM_V);
  float* ws = (float*)(lds + ATT_WS_OFF) + wid * 64; float* li_l = ws; float* al_l = ws + 32;
  float* rpbL = (float*)(lds + ATT_RPB_OFF);
#ifdef T3
  const float C = 0.1275174f, thr_raw = 90.5f;
#else
  const float C = u.C, thr_raw = u.thr_raw;
#endif
  __syncthreads();
  if (MODE == 1) { if (tid < 465) rpbL[tid] = u.rpb[tid] * 11.313708498984761f; }
  const int sr = tid >> 4, sc = (tid & 15) * 8, vst0 = v_st(sr, sc), vst1 = v_st(32 + sr, sc);
  const int vb0 = (int)(uintptr_t)V_lds + v_rd_base(lane);
  const unsigned kvoff = (unsigned)(sr * LDK + sc);
  const int NT = u.nt;
#define TROW(j) ((j) < u.nctx ? u.ctx_row0 + (j) * 64 : u.lat_row0 + ((j) - u.nctx) * 64)
  const int sub = u.sub; {
  float m_reg = -1e29f, l_reg = 0; f32x16 o[4] = {}; bf16x8 qr[8];
  const bf16* Qw = u.Q + (long)(wid * QBLK + r32) * LDK + hi * 8;
  constexpr bool qfull = FULL; const int koff = qfull ? 0 : sub * 128, qoff = qfull ? 0 : sub * 64;
#pragma unroll
  for (int d0 = 0; d0 < 8; ++d0) qr[d0] = St::ld8(Qw + (d0 < 4 ? qoff : 0) + d0 * 16);
  struct { typename St::T vs0, vs1, ks0, ks1; } sr_[SDEPTH];
#define SLOAD(i, tj) do { const long ro_ = (long)TROW(tj) * LDK; const bf16* kb_ = u.K + ro_; const bf16* vb_ = u.V + ro_; sr_[i].vs0 = St::ld8(vb_ + kvoff); sr_[i].vs1 = St::ld8(vb_ + 32 * LDK + kvoff); \
    sr_[i].ks0 = St::ld8(kb_ + kvoff); sr_[i].ks1 = St::ld8(kb_ + 32 * LDK + kvoff); } while (0)
#define SWRITE(b, i) do { *(bf16x8*)((char*)V_lds + (b) * SHM_V + vst0) = St::tobf(sr_[i].vs0);          \
    *(bf16x8*)((char*)V_lds + (b) * SHM_V + vst1) = St::tobf(sr_[i].vs1); int kc = sc * 2;               \
    *(bf16x8*)((char*)K_lds + (b) * SHM_K + KSWZ(sr, kc)) = St::tobf(sr_[i].ks0);                       \
    *(bf16x8*)((char*)K_lds + (b) * SHM_K + KSWZ(32 + sr, kc)) = St::tobf(sr_[i].ks1); } while (0)
#define SWAIT() do { if (SDEPTH == 2) asm volatile("s_waitcnt vmcnt(4)" ::: "memory"); else asm volatile("s_waitcnt vmcnt(0)" ::: "memory"); } while (0)
#define RESC(a) do { if (__any((a) < 1.f)) { if (hi == 0) al_l[r32] = (a); asm volatile("s_waitcnt lgkmcnt(0)" ::: "memory"); \
    for (int d = 0; d < 4; ++d) for (int r = 0; r < 16; ++r) o[d][r] *= al_l[crow(r, hi)]; } } while (0)
  f32x16 pA0, pA1, pB0, pB1; float mnA, mnB, alA, alB; bf16x8 pa0, pa1, pa2, pa3;
  constexpr int SE = 0, SO = SDEPTH - 1;
  if constexpr (MODE == 1 && !B_PIPE) {
  __syncthreads();
  SLOAD(SE, 0); asm volatile("s_waitcnt vmcnt(0)" ::: "memory"); SWRITE(0, SE); __syncthreads();
  for (int j = 0; j < NT; ++j) {
    const int bsel = j & 1;
    if (j + 1 < NT) SLOAD(SE, j + 1);
    SBAR(); qkt<FULL>(pA0, pA1, (bf16*)((char*)K_lds + bsel * SHM_K), qr, r32, hi, koff);
    mask_tile<MODE>(pA0, pA1, j, u, wid, r32, hi, rpbL); partialSM(pA0, pA1, m_reg, mnA, alA, C, thr_raw);
    RESC(alA);
    finishSM(pA0, pA1, alA, l_reg, pa0, pa1, pa2, pa3); SBAR();
    pv_d0(o, vb0 + bsel * (int)SHM_V, pa0, pa1, pa2, pa3);
    if (j + 1 < NT) { asm volatile("s_waitcnt vmcnt(0)" ::: "memory"); if (bsel) SWRITE(0, SE); else SWRITE(1, SE); }
    __syncthreads();
  }
  } else {
  __syncthreads();
  SLOAD(SE, 0); asm volatile("s_waitcnt vmcnt(0)" ::: "memory"); SWRITE(0, SE);
  if (SDEPTH == 1) SLOAD(SO, 1);
  __syncthreads();
  qkt<FULL>(pA0, pA1, K_lds, qr, r32, hi, koff); mask_tile<MODE>(pA0, pA1, 0, u, wid, r32, hi, rpbL); partialSM(pA0, pA1, m_reg, mnA, alA, C, thr_raw);
  if (SDEPTH == 2) { SLOAD(SO, 1); if (2 < NT) SLOAD(SE, 2); }
  SWAIT(); SWRITE(1, SO); __syncthreads();
  for (int j = 1; j + 1 < NT; j += 2) {
#ifdef EARLY_LOAD
    SLOAD(SO, j + SDEPTH); SBAR();
#endif
    SBAR(); qkt<FULL>(pB0, pB1, (bf16*)((char*)K_lds + SHM_K), qr, r32, hi, koff);
    finishSM(pA0, pA1, alA, l_reg, pa0, pa1, pa2, pa3); SGB_QK(); SBAR();
#ifndef EARLY_LOAD
    SLOAD(SO, j + SDEPTH); SBAR();
#endif
    pv_d0(o, vb0, pa0, pa1, pa2, pa3); mask_tile<MODE>(pB0, pB1, j, u, wid, r32, hi, rpbL); partialSM(pB0, pB1, m_reg, mnB, alB, C, thr_raw);
    __syncthreads(); SWAIT(); SWRITE(0, SE);
    RESC(alB); __syncthreads();
#ifdef EARLY_LOAD
    if (SDEPTH == 1 || j + 3 < NT) SLOAD(SE, j + 1 + SDEPTH); SBAR();
#endif
    SBAR(); qkt<FULL>(pA0, pA1, K_lds, qr, r32, hi, koff);
    finishSM(pB0, pB1, alB, l_reg, pa0, pa1, pa2, pa3); SGB_QK(); SBAR();
#ifndef EARLY_LOAD
    if (SDEPTH == 1 || j + 3 < NT) SLOAD(SE, j + 1 + SDEPTH); SBAR();
#endif
    pv_d0(o, vb0 + (int)SHM_V, pa0, pa1, pa2, pa3); mask_tile<MODE>(pA0, pA1, j + 1, u, wid, r32, hi, rpbL); partialSM(pA0, pA1, m_reg, mnA, alA, C, thr_raw);
    __syncthreads(); SWAIT(); SWRITE(1, SO);
    RESC(alA); __syncthreads();
  }
  SBAR(); qkt<FULL>(pB0, pB1, (bf16*)((char*)K_lds + SHM_K), qr, r32, hi, koff);
  finishSM(pA0, pA1, alA, l_reg, pa0, pa1, pa2, pa3); SBAR();
  pv_d0(o, vb0, pa0, pa1, pa2, pa3); mask_tile<MODE>(pB0, pB1, NT - 1, u, wid, r32, hi, rpbL); partialSM(pB0, pB1, m_reg, mnB, alB, C, thr_raw);
  __syncthreads(); RESC(alB);
  finishSM(pB0, pB1, alB, l_reg, pa0, pa1, pa2, pa3); SBAR();
  pv_d0(o, vb0 + (int)SHM_V, pa0, pa1, pa2, pa3);
  }
  asm volatile("s_waitcnt vmcnt(0)" ::: "memory");
  if (u.has_sink) l_reg += __builtin_amdgcn_exp2f(u.sink * 1.4426950408889634f - m_reg * C);
  if (hi == 0) li_l[r32] = l_reg; asm volatile("s_waitcnt lgkmcnt(0)" ::: "memory");
  float rli[16];
#pragma unroll
  for (int r = 0; r < 16; ++r) rli[r] = __builtin_amdgcn_rcpf(li_l[crow(r, hi)]);
#pragma unroll
  for (int r = 0; r < 16; ++r)
#pragma unroll
    for (int d0 = 0; d0 < 4; ++d0) o[d0][r] *= rli[r];
  if (u.nsub == 2) {
    float* sp = u.stash + (long)u.sub * (256 * 128) + (long)(wid * QBLK) * 128 + r32;
#pragma unroll
    for (int r = 0; r < 16; ++r)
#pragma unroll
      for (int d0 = 0; d0 < 4; ++d0) sp[crow(r, hi) * 128 + d0 * 32] = o[d0][r];
  } else {
    bf16* Ow = u.O + (long)(wid * QBLK) * LDO + r32;
#pragma unroll
    for (int r = 0; r < 16; ++r)
#pragma unroll
      for (int d0 = 0; d0 < 4; ++d0) Ow[(long)crow(r, hi) * LDO + d0 * 32] = (bf16)f2bf(o[d0][r]);
  }
  }
#undef TROW
#undef SLOAD
#undef SWRITE
#undef SWAIT
#undef RESC
}

__device__ __forceinline__ void unit_finish(const AttnUnit& u) {
  int tid = threadIdx.x; asm volatile("" : "+v"(tid));
  const int wid = tid >> 6, lane = tid & 63;
  if (u.nsub != 2 || u.sub == 0) return;
  __syncthreads();
  const float* s0 = u.stash + (long)(wid * QBLK) * 128 + 2 * lane; const float* s1 = s0 + 256 * 128;
  unsigned* op = (unsigned*)(u.O + (long)(wid * QBLK) * LDO) + lane;
  if (u.nsub == 2) {
    const float g0 = u.gsub[2 * lane] * u.post, g1 = u.gsub[2 * lane + 1] * u.post;
#pragma unroll 4
    for (int r = 0; r < 32; ++r) {
      const float a0 = s0[r * 128], a1 = s0[r * 128 + 1], b0 = s1[r * 128], b1 = s1[r * 128 + 1];
      const float v0 = a0 - u.lam * b0, v1 = a1 - u.lam * b1;
      float ss = v0 * v0 + v1 * v1;
      ss = ::wave_sum(ss);
      const float rn = 1.0f / sqrtf(ss * (1.0f / 128.0f) + 1e-6f);
      op[(long)r * (LDO / 2)] = pk2(v0 * rn * g0, v1 * rn * g1);
    }
  } else {
#pragma unroll 8
    for (int r = 0; r < 32; ++r) op[(long)r * (LDO / 2)] = pk2(s0[r * 128], s0[r * 128 + 1]);
  }
}
#undef SBAR
#undef KSWZ
}
struct Args { const float* in[22]; float* out; unsigned char* ws; int ph_lo, ph_hi; };
enum { I_X = 0, I_C, I_CTX, I_CCTX, I_GMIX, I_GMLP, I_WMOD, I_BMOD, I_WIN, I_WOUT, I_GQ, I_GK, I_RPB, I_LQ1, I_LK1, I_LQ2, I_LK2, I_GSUB, I_SINK, I_WUP, I_WDN, I_GFIN };
typedef float f32x4g __attribute__((ext_vector_type(4)));
typedef unsigned v4u __attribute__((ext_vector_type(4)));

__device__ __forceinline__ void transpose_item(const float* W, int K, int N, bf16* WT, int ldt, LAS float* scr, int item, int lane) {
    const int nblk = N / 32, kb = item / nblk, nb = item % nblk, k0 = 64 * kb, n0 = 32 * nb;
#pragma unroll 8
    for (int i = 0; i < 32; ++i) { const int kk = 2 * i + (lane >> 5); scr[kk * 33 + (lane & 31)] = W[(size_t)(k0 + kk) * N + n0 + (lane & 31)]; }
    asm volatile("s_waitcnt lgkmcnt(0)" ::: "memory");
    const int c = lane & 7;
#pragma unroll
    for (int j = 0; j < 4; ++j) { const int n = (lane >> 3) + 8 * j; const LAS float* s = scr + (8 * c) * 33 + n;
        v4u o; o.x = pk2(s[0 * 33], s[1 * 33]); o.y = pk2(s[2 * 33], s[3 * 33]); o.z = pk2(s[4 * 33], s[5 * 33]); o.w = pk2(s[6 * 33], s[7 * 33]);
        *(v4u*)(WT + (size_t)(n0 + n) * ldt + k0 + 8 * c) = o; }
    asm volatile("s_waitcnt lgkmcnt(0)" ::: "memory");
}

__device__ __forceinline__ void weight_transposes(const Args& a, unsigned char* lds_, int l, int wg, int nwg_) {
    int tid_ = threadIdx.x; asm volatile("" : "+v"(tid_)); const int lane = tid_ & 63, wave = tid_ >> 6; const int gw = wg * NWAVES + wave, NGW = nwg_ * NWAVES;
    LAS float* scr = (LAS float*)((LAS unsigned char*)lds_ + wave * 16384);
    constexpr int I_IN = (DM / 64) * (PW / 32), I_OUT = (DM / 64) * (DM / 32), I_UP = (DM / 64) * (HID / 32), I_DN = (HID / 64) * (DM / 32), I_L = I_IN + I_OUT + I_UP + I_DN;
    bf16* wt = (bf16*)(a.ws + WS_WT + (size_t)l * WL_B);
    for (int it = gw; it < I_L; it += NGW) {
        int r = it;
        if (r < I_IN) { transpose_item(a.in[I_WIN] + (size_t)l * DM * PW, DM, PW, wt, DM, scr, r, lane); continue; } r -= I_IN;
        if (r < I_OUT) { transpose_item(a.in[I_WOUT] + (size_t)l * DM * DM, DM, DM, (bf16*)((unsigned char*)wt + WIN_B), DM, scr, r, lane); continue; } r -= I_OUT;
        if (r < I_UP) { transpose_item(a.in[I_WUP] + (size_t)l * DM * HID, DM, HID, (bf16*)((unsigned char*)wt + WIN_B + WOUT_B), DM, scr, r, lane); continue; } r -= I_UP;
        transpose_item(a.in[I_WDN] + (size_t)l * HID * DM, HID, DM, (bf16*)((unsigned char*)wt + WIN_B + WOUT_B + WUP_B), HIDP, scr, r, lane);
    }
}

__device__ __forceinline__ void phase_prologue(const Args& a, unsigned char* lds_, int G, int vcu) {
    int tid_ = threadIdx.x; asm volatile("" : "+v"(tid_)); const int tid = tid_, lane = tid & 63, wave = tid >> 6;
    float* cond = (float*)lds_;
    float* part = (float*)(lds_ + 9 * 2048 * 4);
    __syncthreads();
    for (int i = tid; i < 9 * 2048; i += NTHREADS) { const int r = i >> 11, k = i & 2047; const float v = r < 8 ? a.in[I_C][r * 2048 + k] : a.in[I_CCTX][k]; cond[i] = v / (1.0f + expf(-v)); }
    __syncthreads();
    float* MOD = (float*)(a.ws + WS_MOD);
    for (int item = blockIdx.x; item < 768; item += G) {
        const int l = item / 384, n0 = (item % 384) * 32;
        const float* W = a.in[I_WMOD] + (size_t)l * 2048 * MODW + n0;
        const int kq = tid >> 3, c4 = tid & 7;
        float acc[9][4];
#pragma unroll
        for (int r = 0; r < 9; ++r)
#pragma unroll
            for (int j = 0; j < 4; ++j) acc[r][j] = 0.f;
#pragma unroll 2
        for (int i0 = 0; i0 < 32; i0 += 4) {
            f32x4g w[4];
#pragma unroll
            for (int i = 0; i < 4; ++i) w[i] = *(const f32x4g*)(W + (size_t)(kq * 32 + i0 + i) * MODW + c4 * 4);
#pragma unroll
            for (int r = 0; r < 9; ++r) { const f32x4g cv = *(const f32x4g*)(cond + r * 2048 + kq * 32 + i0);
#pragma unroll
                for (int i = 0; i < 4; ++i)
#pragma unroll
                    for (int j = 0; j < 4; ++j) acc[r][j] += cv[i] * w[i][j]; }
        }
#pragma unroll
        for (int r = 0; r < 9; ++r)
#pragma unroll
            for (int j = 0; j < 4; ++j) { float v = acc[r][j]; v = sum_xor<8>(v); v = sum_xor<16>(v); v = sum_xor<32>(v); if (lane < 8) part[(wave * 9 + r) * 32 + c4 * 4 + j] = v; }
        __syncthreads();
        if (tid < 288) { const int r = tid >> 5, n = tid & 31; float s = 0.f;
#pragma unroll
            for (int w = 0; w < 8; ++w) s += part[(w * 9 + r) * 32 + n];
            MOD[(size_t)(l * 9 + r) * MODW + n0 + n] = s + a.in[I_BMOD][l * MODW + n0 + n]; }
        __syncthreads();
    }
    weight_transposes(a, lds_, 0, vcu, G); weight_transposes(a, lds_, 1, vcu, G);
    float* cosH = (float*)(a.ws + WS_ROPE); float* sinH = cosH + 2048 * 64; float* cosD = sinH + 2048 * 64; float* sinD = cosD + 2048 * 32;
    for (int i = blockIdx.x * NTHREADS + tid; i < 2048 * 96; i += G * NTHREADS) {
        if (i < 2048 * 64) { const int t = i >> 6, p = i & 63; const float pos = (float)(p < 32 ? (t >> 6) : (t & 63)); const float f = powf(10000.0f, -(float)(p & 31) / 32.0f); const float ang = pos * f; cosH[i] = cosf(ang); sinH[i] = sinf(ang); }
        else { const int k = i - 2048 * 64, t = k >> 5, p = k & 31; const float pos = (float)(p < 16 ? (t >> 6) : (t & 63)); const float f = powf(10000.0f, -(float)(p & 15) / 16.0f); const float ang = pos * f; cosD[k] = cosf(ang); sinD[k] = sinf(ang); }
    }
}

__device__ __forceinline__ void phase_norm(const void* xa, bool xa_bf16, const void* xb, bool xb_bf16, int M, const float* g, const float* modl, int shift_slot, int scale_slot, bf16* out, const float* part, const float* pgate, bf16* wb, int G, int vcu) {
    int tid_ = threadIdx.x; asm volatile("" : "+v"(tid_)); const int lane = tid_ & 63, wave = tid_ >> 6; const int gw = vcu * NWAVES + wave, NGW = G * NWAVES;
    for (int m = gw; m < M; m += NGW) {
        const int b = m < MX ? (m >> 11) : 8; const bool isb = m < MX ? xa_bf16 : xb_bf16; const size_t ro = m < MX ? (size_t)m * DM : (size_t)(m - MX) * DM; const void* src = m < MX ? xa : xb;
        f32x4g v[8]; float s = 0.f;
        if (isb) { const unsigned long long* bp = (const unsigned long long*)((const bf16*)src + ro) + lane;
#pragma unroll
            for (int j = 0; j < 8; ++j) { const unsigned long long w = bp[64 * j]; v[j].x = bf2f((unsigned)w & 0xffffu); v[j].y = bf2f(((unsigned)w) >> 16); v[j].z = bf2f((unsigned)(w >> 32) & 0xffffu); v[j].w = bf2f((unsigned)(w >> 48)); } }
        else { const f32x4g* xp = (const f32x4g*)((const float*)src + ro) + lane;
#pragma unroll
            for (int j = 0; j < 8; ++j) v[j] = xp[64 * j]; }
        if (part != nullptr && m >= MX) { const f32x4g* pp = (const f32x4g*)(part + (size_t)(m - MX) * DM) + lane; const f32x4g* pg = (const f32x4g*)pgate + lane;
#pragma unroll
            for (int j = 0; j < 8; ++j) { const f32x4g q = (pp[64 * j] + pp[64 * j + (size_t)MC * DM / 4]) + (pp[64 * j + 2 * ((size_t)MC * DM / 4)] + pp[64 * j + 3 * ((size_t)MC * DM / 4)]); v[j] += pg[64 * j] * q; }
            if (wb != nullptr) { unsigned long long* wp = (unsigned long long*)(wb + (size_t)(m - MX) * DM) + lane;
#pragma unroll
                for (int j = 0; j < 8; ++j) wp[64 * j] = (unsigned long long)pk2(v[j].x, v[j].y) | ((unsigned long long)pk2(v[j].z, v[j].w) << 32); } }
#pragma unroll
        for (int j = 0; j < 8; ++j) s += (v[j].x * v[j].x + v[j].y * v[j].y) + (v[j].z * v[j].z + v[j].w * v[j].w);
        const float rstd = 1.0f / sqrtf(wave_sum(s) * (1.0f / DM) + NORM_EPS);
        const f32x4g* gp = (const f32x4g*)g + lane; const f32x4g* shp = (const f32x4g*)(modl + (size_t)b * MODW + shift_slot * DM) + lane; const f32x4g* scp = (const f32x4g*)(modl + (size_t)b * MODW + scale_slot * DM) + lane;
        unsigned long long* o8 = (unsigned long long*)(out + (size_t)m * DM) + lane;
#pragma unroll
        for (int j = 0; j < 8; ++j) { const f32x4g gg = gp[64 * j], sh = shp[64 * j], sc = scp[64 * j]; const f32x4g y = (v[j] * rstd) * gg * (sc + 1.0f) + sh;
            o8[64 * j] = (unsigned long long)pk2(y.x, y.y) | ((unsigned long long)pk2(y.z, y.w) << 32); }
    }
}
__device__ __forceinline__ void phase_final(const bf16* x, const float* g, float* out, int G, int vcu) {
    int tid_ = threadIdx.x; asm volatile("" : "+v"(tid_)); const int lane = tid_ & 63, wave = tid_ >> 6; const int gw = vcu * NWAVES + wave, NGW = G * NWAVES;
    for (int m = gw; m < MX; m += NGW) {
        const unsigned long long* bp = (const unsigned long long*)(x + (size_t)m * DM) + lane; f32x4g v[8]; float s = 0.f;
#pragma unroll
        for (int j = 0; j < 8; ++j) { const unsigned long long w = bp[64 * j]; v[j].x = bf2f((unsigned)w & 0xffffu); v[j].y = bf2f(((unsigned)w) >> 16); v[j].z = bf2f((unsigned)(w >> 32) & 0xffffu); v[j].w = bf2f((unsigned)(w >> 48));
            s += (v[j].x * v[j].x + v[j].y * v[j].y) + (v[j].z * v[j].z + v[j].w * v[j].w); }
        const float rstd = 1.0f / sqrtf(wave_sum(s) * (1.0f / DM) + NORM_EPS);
        const f32x4g* gp = (const f32x4g*)g + lane; f32x4g* op = (f32x4g*)(out + (size_t)m * DM) + lane;
#pragma unroll
        for (int j = 0; j < 8; ++j) op[64 * j] = (v[j] * rstd) * gp[64 * j];
    }
}

__device__ __forceinline__ void phase_qkprep(bf16* P, const float* gq, const float* gk, const float* rope, int G, int vcu) {
    int tid_ = threadIdx.x; asm volatile("" : "+v"(tid_)); const int lane = tid_ & 63, wave = tid_ >> 6; const int gw = vcu * NWAVES + wave, NGW = G * NWAVES;
    const float* cosH = rope; const float* sinH = cosH + 2048 * 64; const float* cosD = sinH + 2048 * 64; const float* sinD = cosD + 2048 * 32;
    const float gq0 = gq[2 * lane], gq1 = gq[2 * lane + 1], gk0 = gk[2 * lane], gk1 = gk[2 * lane + 1];
    for (int m = gw; m < MT; m += NGW) {
        const bool lat = m < MX; const int pos = m & 2047;
        unsigned* row = (unsigned*)(P + (size_t)m * PW) + lane;
        float cH = 1.f, sH = 0.f, cD = 1.f, sD = 0.f;
        if (lat) { cH = cosH[pos * 64 + lane]; sH = sinH[pos * 64 + lane]; cD = cosD[pos * 32 + (lane & 31)]; sD = sinD[pos * 32 + (lane & 31)]; }
#pragma unroll
        for (int blk = 0; blk < 6; ++blk) {
            const unsigned w = row[blk * 64]; float x0 = bf2f(w & 0xffffu), x1 = bf2f(w >> 16);
            const float ss = wave_sum(x0 * x0 + x1 * x1); const float rn = 1.0f / sqrtf(ss * (1.0f / 128.0f) + NORM_EPS);
            x0 = x0 * rn * (blk < 4 ? gq0 : gk0); x1 = x1 * rn * (blk < 4 ? gq1 : gk1);
            const float y0 = x0 * cH - x1 * sH, y1 = x0 * sH + x1 * cH;
            row[blk * 64] = pk2(y0, y1);
        }
        if (lat) {
#pragma unroll
            for (int blk = 0; blk < 8; ++blk) {
                const unsigned w = row[(2560 / 2) + blk * 64]; const float x0 = bf2f(w & 0xffffu), x1 = bf2f(w >> 16);
                row[(2560 / 2) + blk * 64] = pk2(x0 * cD - x1 * sD, x0 * sD + x1 * cD);
            }
#pragma unroll
            for (int blk = 0; blk < 6; ++blk) {
                const unsigned w = row[(4096 / 2) + blk * 64]; const float x0 = bf2f(w & 0xffffu), x1 = bf2f(w >> 16);
                row[(4096 / 2) + blk * 64] = pk2(x0 * cH - x1 * sH, x0 * sH + x1 * cH);
            }
        }
    }
}

#ifndef AM1
#define AM1 1
#define AM2 2
#endif
__device__ __forceinline__ void phase_attention(const Args& a, int layer, unsigned char* lds_, int G, int vcu) {
    bf16* P = (bf16*)(a.ws + WS_P); bf16* AO = (bf16*)(a.ws + WS_AO);
    const float LOG2E = 1.4426950408889634f;
    const float lam_init = 0.8f - 0.6f * expf(-0.3f * (float)layer);
    float lam;
    { int lane = threadIdx.x & 63; asm volatile("" : "+v"(lane)); const float* q1 = a.in[I_LQ1] + layer * 64, *k1 = a.in[I_LK1] + layer * 64, *q2 = a.in[I_LQ2] + layer * 64, *k2 = a.in[I_LK2] + layer * 64;
      const float s1 = wave_sum(q1[lane] * k1[lane]), s2 = wave_sum(q2[lane] * k2[lane]); lam = expf(s1) - expf(s2) + lam_init; lam = __builtin_bit_cast(float, __builtin_amdgcn_readfirstlane(__builtin_bit_cast(int, lam))); }
    const int nround = layer == 0 ? 7 : 5;
    for (int vu = vcu; vu < 256; vu += G) {
    for (int round = 0; round < nround; ++round) {
        att::AttnUnit u; int type, b, h, qb; bool isctx = false; u.sub = 0;
        if (round < 5) { b = vu >> 5; h = (vu >> 3) & 3; qb = vu & 7;
            const int rr = (h < 2) ? round : (round + 2) % 5;
            type = rr < 2 ? 2 : (rr == 2 ? 0 : (rr == 3 ? 1 : 3)); u.sub = rr == 1 ? 1 : 0; }
        else { if (vu & 1) continue; const int idx = vu >> 1; b = idx >> 4; type = (idx >> 2) & 3; h = idx & 3; qb = 0; isctx = true; if (round == 6) { if (type != 2) continue; u.sub = 1; } }
        const int kvh = (type == 0 || type == 3) ? (h >> 1) : h;
        const int qcol = type == 0 ? h * 128 : type == 1 ? 1024 + h * 128 : type == 2 ? 2560 + h * 128 : 4096 + h * 128;
        const int kcol = type == 0 ? 512 + kvh * 128 : type == 1 ? 1536 + kvh * 128 : type == 2 ? 3072 + kvh * 128 : 4608 + kvh * 128;
        const int vcol = type == 0 ? 768 + kvh * 128 : type == 1 ? 2048 + kvh * 128 : type == 2 ? 3584 + kvh * 128 : 4864 + kvh * 128;
        const int ocol = type * 512 + h * 128;
        const int qrow0 = isctx ? MX + b * CTXL : b * SEQ + qb * 256;
        u.Q = P + ((size_t)(qcol >> 7) * MT + qrow0) * 128; u.K = P + (size_t)(kcol >> 7) * MT * 128; u.V = P + (size_t)(vcol >> 7) * MT * 128; u.O = AO + (size_t)qrow0 * DM + ocol;
        u.ctx_row0 = MX + b * CTXL; u.nctx = 4; u.qpos0 = qb * 256;
        int t_lo = 0, nlat = 32;
        if (isctx) nlat = 0;
        else if (type == 1) { const int r0 = qb * 4; int lo = r0 - 4; lo = lo < 0 ? 0 : (lo > 24 ? 24 : lo); int hi = r0 - 1; hi = hi < 0 ? 0 : (hi > 24 ? 24 : hi); hi += 8; if ((hi - lo) & 1) hi += 1; t_lo = lo; nlat = hi - lo; }
        else if (type == 3) { int lo = qb * 4 - 2; lo = lo < 0 ? 0 : lo; int hi = qb * 4 + 6; hi = hi > 32 ? 32 : hi; t_lo = lo; nlat = hi - lo; }
        u.lat_row0 = b * SEQ + t_lo * 64; u.kpos0 = t_lo * 64; u.nt = 4 + nlat;
        const float scale = type == 2 ? 0.125f : 0.088388347648318440f;
        u.C = scale * LOG2E; u.thr_raw = 8.0f / scale;
        u.nsub = type == 2 ? 2 : 1; u.lam = lam; u.post = 1.0f - lam_init; u.gsub = a.in[I_GSUB] + layer * 128;
        u.has_sink = type == 3; u.sink = type == 3 ? a.in[I_SINK][layer * 4 + h] : 0.f;
        u.rpb = a.in[I_RPB] + (size_t)(layer * 4 + h) * 465;
        u.stash = (float*)(a.ws + WS_STASH) + (size_t)blockIdx.x * 2 * 256 * 128;
#ifdef ATT_DUP_ROUND
        for (int dup_ = 0; dup_ < (round == ATT_DUP_ROUND ? 2 : 1); ++dup_) {
#else
        {
#endif
        if (!isctx && type == 1) att::attn_unit<AM1, true>(u, (char*)lds_);
        else if (!isctx && type == 3) att::attn_unit<AM2, true>(u, (char*)lds_);
        else if (type == 2) att::attn_unit<0, false>(u, (char*)lds_);
        else att::attn_unit<0, true>(u, (char*)lds_);
        att::unit_finish(u);
        }
    }
    }
}
#ifndef PHMASK
#define PHMASK 1023
#endif
#ifndef REP_ATT
#define REP_ATT 1
#endif
#ifndef REP_UP
#define REP_UP 1
#endif
#ifndef REP_IN
#define REP_IN 1
#endif
#ifndef REP_PRO
#define REP_PRO 1
#endif
#ifndef REP_SYNC
#define REP_SYNC 1
#endif
#ifndef REP_NORM
#define REP_NORM 1
#endif
#ifndef REP_INQK
#define REP_INQK 1
#endif
#ifndef REP_DN
#define REP_DN 1
#endif
#ifndef DN_WGM
#define DN_WGM 4
#endif
#ifndef USE_XB
#define USE_XB 0
#endif
#ifndef RES_SP2
#define RES_SP2 true
#endif
#ifndef DN_KCH
#define DN_KCH 1
#endif
#ifndef MK_COOP
#define MK_COOP 1
#endif
constexpr int N_PHASES = 18;
__global__ void __launch_bounds__(NTHREADS) fwd_kernel(Args a) {
    extern __shared__ __attribute__((aligned(16))) unsigned char lds[];
    cg::grid_group grid = cg::this_grid();
    const int G = gridDim.x, bx = blockIdx.x;
    const int vcu = (G % 8 == 0) ? (bx % 8) * (G / 8) + bx / 8 : bx;
#define IN(k) (a.ph_lo <= (k) && (k) < a.ph_hi)
#define SEAM(k) do { if (IN(k) && IN((k) + 1)) for (int rs_ = 0; rs_ < REP_SYNC; ++rs_) { if (a.ph_lo < 0) grid.sync(); else xcd_barrier(xbar); }     } while (0)
    unsigned char* ws = a.ws;
    volatile LAS unsigned* xst = (volatile LAS unsigned*)((LAS unsigned char*)lds + 131072 + 64);
    if (threadIdx.x < 2) xst[threadIdx.x] = 0u;
    __syncthreads();
    XcdBarrier xbar; xbar.bar = (unsigned*)ws; xbar.x = 0; xbar.st = nullptr;
    if (a.ph_hi - a.ph_lo > 1) xbar = xcd_barrier_post((unsigned*)ws, xst);
    #if PHMASK & 1
    if (IN(0)) for (int rep_ = 0; rep_ < REP_PRO; ++rep_) phase_prologue(a, lds, G, vcu);
#endif
    SEAM(0);
    for (int l = 0; l < 2; ++l) {
        const int pb = 1 + 8 * l;
        asm volatile("" : "+s"(ws));
        bf16* X = (bf16*)(ws + WS_X); bf16* H0 = (bf16*)(ws + WS_H0); bf16* P = (bf16*)(ws + WS_P); bf16* AO = (bf16*)(ws + WS_AO); bf16* HM = (bf16*)(ws + WS_BIG);
        const float* modl = (const float*)(ws + WS_MOD) + (size_t)l * 9 * MODW;
        const bf16* Win = (const bf16*)(ws + WS_WT + (size_t)l * WL_B); const bf16* Wout = (const bf16*)((const unsigned char*)Win + WIN_B);
        const bf16* Wup = (const bf16*)((const unsigned char*)Wout + WOUT_B); const bf16* Wdn = (const bf16*)((const unsigned char*)Wup + WUP_B);
        const int M2 = l == 0 ? MT : MX;
#if PHMASK & 2
        if (IN(pb + 0)) for (int rep_ = 0; rep_ < REP_NORM; ++rep_) phase_norm(l == 0 ? (const void*)a.in[I_X] : (const void*)X, l == 1, l == 0 ? (const void*)a.in[I_CTX] : (const void*)(X + (size_t)MX * DM), l == 1, MT, a.in[I_GMIX] + l * DM, modl, 0, 1, H0, l == 1 ? (const float*)(ws + WS_STASH) : nullptr, (const float*)(ws + WS_MOD) + 8 * MODW + 5 * DM, nullptr, G, vcu);
#endif
        SEAM(pb + 0);
        for (int rq_ = 0; rq_ < REP_INQK; ++rq_) {
#if PHMASK & 4
        if (IN(pb + 1)) for (int rep_ = 0; rep_ < REP_IN; ++rep_) { pg8::Gemm g{H0, Win, MT, PW, DM, DM}; pg8::StaticOrder S; S.init(MT, PW, G, bx); pg8::EpiInProj E{P, MT, a.in[I_GQ] + l * 128, a.in[I_GK] + l * 128, (const float*)(ws + WS_ROPE), (LAS float*)((LAS unsigned char*)lds + 131072 + 1024)};
            pg8::gemm_phase<pg8::EpiInProj, pg8::StaticOrder, true, true>((LAS unsigned char*)lds, g, S, E); }
#endif
        SEAM(pb + 1);
        }
#if PHMASK & 16
        if (IN(pb + 3)) for (int rep_ = 0; rep_ < REP_ATT; ++rep_) phase_attention(a, l, lds, G, vcu);
#endif
        SEAM(pb + 3);
#if PHMASK & 32
        if (IN(pb + 4)) {
            { pg8::Gemm g{AO, Wout, MX, DM, DM, DM}; pg8::ChunkOrder S; S.init(MX, DM, G, bx, 8, 1);
              if (l == 0) { pg8::EpiResidB<true> E{a.in[I_X], nullptr, X, modl + 2 * DM}; pg8::gemm_phase<pg8::EpiResidB<true>, pg8::ChunkOrder, true, RES_SP2>((LAS unsigned char*)lds, g, S, E); }
              else { pg8::EpiResidB<false> E{nullptr, X, X, modl + 2 * DM}; pg8::gemm_phase<pg8::EpiResidB<false>, pg8::ChunkOrder, true, RES_SP2>((LAS unsigned char*)lds, g, S, E); } }
            if (l == 0) {
              pg8::Gemm g{AO, Wout, MT, DM, DM, DM / 4}; pg8::SplitOrder S; S.init(MX / 256, MC / 256, DM / 256, 4, G, bx); pg8::EpiPart E{(float*)(ws + WS_STASH), MX / 256, (size_t)MC * DM};
              pg8::gemm_phase<pg8::EpiPart, pg8::SplitOrder, true, true>((LAS unsigned char*)lds, g, S, E); }
        }
#endif
        SEAM(pb + 4);
#if PHMASK & 64
        if (IN(pb + 5)) for (int rep_ = 0; rep_ < REP_NORM; ++rep_) phase_norm(X, true, l == 0 ? (const void*)a.in[I_CTX] : (const void*)(X + (size_t)MX * DM), l == 1, M2, a.in[I_GMLP] + l * DM, modl, 3, 4, H0, l == 0 ? (const float*)(ws + WS_STASH) : nullptr, (const float*)(ws + WS_MOD) + 8 * MODW + 2 * DM, l == 0 ? X + (size_t)MX * DM : nullptr, G, vcu);
#endif
        SEAM(pb + 5);
#if PHMASK & 128
        if (IN(pb + 6)) for (int rep_ = 0; rep_ < REP_UP; ++rep_) { pg8::Gemm g{H0, Wup, M2, HID, DM, DM}; pg8::StaticOrder S; S.init(M2, HID, G, bx); pg8::EpiStore<1> E{HM, HIDP};
            pg8::gemm_phase<pg8::EpiStore<1>, pg8::StaticOrder, true, true>((LAS unsigned char*)lds, g, S, E); }
#endif
        SEAM(pb + 6);
#if PHMASK & 256
        if (IN(pb + 7)) {
            { const int nch = (((MX / 256) * (DM / 256)) % G == 0) ? DN_KCH : 1;
              pg8::Gemm g{HM, Wdn, MX, DM, HIDP, HID / nch}; pg8::ChunkOrder S; S.init(MX, DM, G, bx, DN_WGM, nch); pg8::EpiResidB<false> E{nullptr, X, X, modl + 5 * DM};
              pg8::gemm_phase<pg8::EpiResidB<false>, pg8::ChunkOrder, true, RES_SP2>((LAS unsigned char*)lds, g, S, E); }
            if (l == 0) {
              pg8::Gemm g{HM, Wdn, MT, DM, HIDP, HID / 4}; pg8::SplitOrder S; S.init(MX / 256, MC / 256, DM / 256, 4, G, bx); pg8::EpiPart E{(float*)(ws + WS_STASH), MX / 256, (size_t)MC * DM};
              pg8::gemm_phase<pg8::EpiPart, pg8::SplitOrder, true, true>((LAS unsigned char*)lds, g, S, E); }
        }
#endif
        SEAM(pb + 7);
    }
#if PHMASK & 512
    if (IN(17)) phase_final((const bf16*)(ws + WS_X), a.in[I_GFIN], a.out, G, vcu);
#endif
#undef IN
#undef SEAM
}

extern "C" void kernel_launch(void* const* d_in, const int* in_sizes, int n_in, void* d_out, int out_size, void* d_ws, size_t ws_size, hipStream_t stream) {
    static int grid = 0;
    if (grid == 0) {
        if (n_in != 22 || out_size != MX * DM || ws_size < WS_END) { fprintf(stderr, "kernel_launch: unexpected shapes (n_in %d out %d ws %zu need %zu)\n", n_in, out_size, ws_size, (size_t)WS_END); grid = -1; return; }
        int dev = 0, cus = 0, per_cu = 0;
        hipGetDevice(&dev); hipDeviceGetAttribute(&cus, hipDeviceAttributeMultiprocessorCount, dev);
        if (hipFuncSetAttribute((const void*)fwd_kernel, hipFuncAttributeMaxDynamicSharedMemorySize, LDS_BYTES) != hipSuccess) { fprintf(stderr, "kernel_launch: hipFuncSetAttribute failed\n"); grid = -1; return; }
        if (hipOccupancyMaxActiveBlocksPerMultiprocessor(&per_cu, (const void*)fwd_kernel, NTHREADS, LDS_BYTES) != hipSuccess || per_cu < 1) { fprintf(stderr, "kernel_launch: occupancy query gave %d\n", per_cu); per_cu = 1; }
        (void)hipGetLastError();
        grid = cus * per_cu;
        fprintf(stderr, "kernel_launch: grid %d (cus %d x %d)\n", grid, cus, per_cu);
    }
    if (grid < 0) return;
    (void)hipMemsetAsync(d_ws, 0, 16384, stream);
    Args a{};
    for (int i = 0; i < 22; ++i) a.in[i] = (const float*)d_in[i];
    a.out = (float*)d_out; a.ws = (unsigned char*)d_ws;
#if MK_COOP
    a.ph_lo = 0; a.ph_hi = N_PHASES;
    void* args[] = {&a};
    hipError_t e = hipLaunchCooperativeKernel((const void*)fwd_kernel, dim3(grid), dim3(NTHREADS), args, LDS_BYTES, stream);
    if (e != hipSuccess) fprintf(stderr, "kernel_launch: cooperative launch failed: %s (grid %d)\n", hipGetErrorString(e), grid);
#else
    for (int ph = 0; ph < N_PHASES; ++ph) { a.ph_lo = ph; a.ph_hi = ph + 1; hipLaunchKernelGGL(fwd_kernel, dim3(grid), dim3(NTHREADS), LDS_BYTES, stream, a); }
#endif
}
```

```cpp
#include <hip/hip_runtime.h>
#include <hip/hip_cooperative_groups.h>
#include <cstdio>
#include <cstdint>
namespace cg = cooperative_groups;

constexpr int DM = 2048, NB = 8, SEQ = 2048, CTXL = 256, PW = 5120, HID = 8192, HIDP = HID + 64  , NMOD = 6, MODW = NMOD * DM;
constexpr int MX = NB * SEQ, MC = NB * CTXL, MT = MX + MC;
constexpr float NORM_EPS = 1e-6f;
constexpr int NWAVES = 8, NTHREADS = 512;
constexpr int LDS_BYTES = 147456;
constexpr size_t WIN_B = (size_t)PW * DM * 2, WOUT_B = (size_t)DM * DM * 2, WUP_B = (size_t)HID * DM * 2, WDN_B = (size_t)DM * HIDP * 2, WL_B = WIN_B + WOUT_B + WUP_B + WDN_B;
constexpr size_t WS_WT = 1u << 20;
constexpr size_t WS_MOD = WS_WT + 2 * WL_B;
constexpr size_t MOD_B = (size_t)2 * 9 * MODW * 4;
constexpr size_t WS_ROPE = WS_MOD + MOD_B;
constexpr size_t ROPE_B = (size_t)2048 * 64 * 4 * 2 + (size_t)2048 * 32 * 4 * 2;
constexpr size_t WS_X = WS_ROPE + ROPE_B;
constexpr size_t X_B = (size_t)MT * DM * 4;
constexpr size_t WS_H0 = WS_X + X_B;
constexpr size_t H0_B = (size_t)MT * DM * 2;
constexpr size_t WS_BIG = WS_H0 + H0_B;
constexpr size_t BIG_B = (size_t)MT * HIDP * 2;
constexpr size_t WS_P = WS_BIG, P_B = (size_t)MT * PW * 2;
constexpr size_t WS_AO = WS_P + P_B, AO_B = (size_t)MT * DM * 2;
static_assert(WS_AO + AO_B <= WS_BIG + BIG_B, "overlay");
constexpr size_t WS_STASH = WS_BIG + BIG_B, STASH_B = (size_t)256 * 2 * 256 * 128 * 4;
constexpr size_t WS_END = WS_STASH + STASH_B;
static_assert(WS_MOD % 256 == 0 && WS_ROPE % 256 == 0 && WS_X % 256 == 0 && WS_H0 % 256 == 0 && WS_BIG % 256 == 0 && WS_AO % 256 == 0 && WS_STASH % 256 == 0, "align");

typedef unsigned short bf16;
#define LAS __attribute__((address_space(3)))
__device__ __forceinline__ float bf2f(unsigned v) { return __builtin_bit_cast(float, v << 16); }
__device__ __forceinline__ unsigned f2bf(float f) { unsigned u = __builtin_bit_cast(unsigned, f); return (u + 0x7fffu + ((u >> 16) & 1u)) >> 16; }
__device__ __forceinline__ unsigned pk2(float lo, float hi) { return f2bf(lo) | (f2bf(hi) << 16); }
template <int K> __device__ __forceinline__ float sum_xor(float v) {
    if constexpr (K < 32) return v + __builtin_bit_cast(float, __builtin_amdgcn_ds_swizzle(__builtin_bit_cast(int, v), (K << 10) | 0x1f));
    else { const unsigned b = __builtin_bit_cast(unsigned, v); auto rr = __builtin_amdgcn_permlane32_swap(b, b, false, false); return __builtin_bit_cast(float, (unsigned)rr[0]) + __builtin_bit_cast(float, (unsigned)rr[1]); }
}
__device__ __forceinline__ float wave_sum(float v) {
    v = sum_xor<1>(v); v = sum_xor<2>(v); v = sum_xor<4>(v); v = sum_xor<8>(v); v = sum_xor<16>(v); v = sum_xor<32>(v);
    return v;
}
#define MK_COOP 1
#define EPB_NBF 2
#define EPB_NBH 4
#define XB_TMO      128
#define XB_XCNT(j)  (256  + 64 * (j))
#define XB_XSUB(j)  (1280 + 64 * (j))
#define XB_XGEN(j)  (2304 + 64 * (j))
#define XB_TOP      3328
#define XB_TOPGEN   3392
#define XCD_BAR_WORDS 3456
#define XB_SPIN_CAP (1u << 18)

__device__ __forceinline__ unsigned xb_ld(unsigned* p)              { return __hip_atomic_load(p, __ATOMIC_RELAXED, __HIP_MEMORY_SCOPE_AGENT); }
__device__ __forceinline__ unsigned xb_add(unsigned* p, unsigned v) { return __hip_atomic_fetch_add(p, v, __ATOMIC_RELAXED, __HIP_MEMORY_SCOPE_AGENT); }
__device__ __forceinline__ unsigned xb_xcc_id() { return (unsigned)__builtin_amdgcn_s_getreg((3 << 11) | 20) & 0xFu; }
#define XB_SPIN(cond, bar) do { unsigned _sp = 0; while (cond) { __builtin_amdgcn_s_sleep(1); \
    if ((++_sp & 255u) == 0u) { if (xb_ld(&(bar)[XB_TMO])) break; if (_sp > XB_SPIN_CAP) { atomicAdd(&(bar)[XB_TMO], 1u); break; } } } } while (0)

struct XcdBarrier {
    unsigned* bar; unsigned x;
    volatile LAS unsigned* st;
};

__device__ __forceinline__ XcdBarrier xcd_barrier_post(unsigned* bar, volatile LAS unsigned* st) {
    XcdBarrier b; b.bar = bar; b.x = xb_xcc_id(); b.st = st;
    if (threadIdx.x == 0) (void)xb_add(&bar[XB_XCNT(b.x)], 1u);
    return b;
}
__device__ __forceinline__ void xcd_barrier_complete(unsigned* bar, unsigned x, unsigned& nloc, unsigned& nx) {
    const unsigned G = gridDim.x * gridDim.y * gridDim.z;
    unsigned sum, cnt, mine, sp = 0u;
    for (;;) {
        sum = 0u; cnt = 0u; mine = 0u;
#pragma unroll
        for (unsigned j = 0; j < 16; ++j) { const unsigned c = xb_ld(&bar[XB_XCNT(j)]); sum += c; cnt += (c > 0u) ? 1u : 0u; mine = (j == x) ? c : mine; }
        if (sum == G) break;
        __builtin_amdgcn_s_sleep(1);
        if ((++sp & 255u) == 0u) { if (xb_ld(&bar[XB_TMO])) break; if (sp > XB_SPIN_CAP) { atomicAdd(&bar[XB_TMO], 1u); break; } }
    }
    nloc = mine > 0u ? mine : 1u; nx = cnt > 0u ? cnt : 1u;
}

__device__ __forceinline__ void xcd_barrier(const XcdBarrier& b) {
    asm volatile("s_waitcnt vmcnt(0)" ::: "memory");
    __syncthreads();
    if (threadIdx.x == 0) {
        unsigned* bar = b.bar;
        __builtin_amdgcn_s_waitcnt(0);
        unsigned nloc = b.st[0], nx = b.st[1];
        if (nloc == 0u) { xcd_barrier_complete(bar, b.x, nloc, nx); b.st[0] = nloc; b.st[1] = nx; }
        const unsigned old = xb_add(&bar[XB_XSUB(b.x)], 1u);
        const unsigned gen = old / nloc;
        if (old + 1u == (gen + 1u) * nloc) {
            __builtin_amdgcn_fence(__ATOMIC_RELEASE, "agent");
            asm volatile("s_waitcnt vmcnt(0)" ::: "memory");
            const unsigned og = xb_add(&bar[XB_TOP], 1u);
            const unsigned tg = og / nx;
            if (og + 1u == (tg + 1u) * nx) xb_add(&bar[XB_TOPGEN], 1u);
            else XB_SPIN(xb_ld(&bar[XB_TOPGEN]) == tg, bar);
            __builtin_amdgcn_fence(__ATOMIC_ACQUIRE, "agent");
            xb_add(&bar[XB_XGEN(b.x)], 1u);
            asm volatile("s_waitcnt vmcnt(0)" ::: "memory");
        } else {
            XB_SPIN(xb_ld(&bar[XB_XGEN(b.x)]) == gen, bar);
            __builtin_amdgcn_fence(__ATOMIC_ACQUIRE, "agent");
            asm volatile("s_waitcnt vmcnt(0)" ::: "memory");
        }
    }
    __syncthreads();
}
namespace pg8 {
#define PG8_LAS __attribute__((address_space(3)))
typedef unsigned short bf16_t;
typedef short bf16x8 __attribute__((ext_vector_type(8)));
typedef float f32x4 __attribute__((ext_vector_type(4)));
typedef unsigned u32x4 __attribute__((ext_vector_type(4)));
constexpr int BM = 256, BK = 64, HALF = 128, HTB = HALF * BK * 2  , STAGE_BYTES = 8 * HTB, NXCD = 8, WGM = 8;

__host__ __device__ __forceinline__ int lds_byte(int r, int c) { const int st = (r >> 4) * 2 + (c >> 5), rr = r & 15, cc = c & 31, ob = rr * 64 + cc * 2; return st * 1024 + (ob ^ (((ob >> 9) & 1) << 5)); }
__host__ __device__ __forceinline__ void stage_rc(int b, int& R, int& C) { const int st = b / 1024, sb = b % 1024, swz = sb ^ (((sb >> 9) & 1) << 5); R = (st >> 1) * 16 + swz / 64; C = (st & 1) * 32 + (swz % 64) / 2; }
__host__ __device__ __forceinline__ int perm32(int rho) { const int n = rho >> 4, i = rho & 15; return 8 * (i >> 2) + 4 * n + (i & 3); }

struct Unit { int pm, pn, ks; };
struct Gemm { const bf16_t* A; const bf16_t* Bt; int M, N, K, Kext; };

struct StaticOrder {
    int nM, nN, nwg, G, c, wgm;
    __host__ __device__ void init(int M, int N, int G_, int c_, int wgm_ = WGM) { nM = M / BM; nN = N / BM; nwg = nM * nN; G = G_; c = c_; wgm = wgm_; }
    __host__ __device__ bool next(int i, Unit& u) const {
        const long L = (long)i * G + c; if (L >= nwg) return false;
        int wgid = (int)L; { const int q = nwg / NXCD, r = nwg % NXCD, xcd = wgid % NXCD, off = wgid / NXCD; wgid = (xcd < r ? xcd * (q + 1) : r * (q + 1) + (xcd - r) * q) + off; }
        const int nig = wgm * nN, gid = wgid / nig, fm = gid * wgm, gsz = (nM - fm) < wgm ? (nM - fm) : wgm;
        u.pm = fm + ((wgid % nig) % gsz); u.pn = (wgid % nig) / gsz; u.ks = 0; return true;
    }
    __device__ __forceinline__ void a_ready(const Unit&) const {}
    __device__ __forceinline__ void done(const Unit&) const {}
};

__device__ __forceinline__ unsigned cvt_pk_bf16(float lo, float hi) { unsigned r; asm volatile("v_cvt_pk_bf16_f32 %0, %1, %2" : "=v"(r) : "v"(lo), "v"(hi)); return r; }
typedef float f32x2 __attribute__((ext_vector_type(2)));
#ifdef EPI_NT
#define EPI_ST(T, p, v) __builtin_nontemporal_store((v), (T*)(p))
#else
#define EPI_ST(T, p, v) (*(T*)(p) = (v))
#endif
template <int ACT> struct EpiStore {
    static constexpr bool PERM = true, AFTER_DRAIN = false;
    bf16_t* O; int ldc;
    __device__ __forceinline__ void operator()(const f32x4 (&acc)[2][2][4][2], const Unit& u, int wr, int wc, int fr, int fq) const {
        const int row0 = u.pm * BM + wr * 64 + fr; const int col0 = u.pn * BM + wc * 32 + 8 * fq;
#pragma unroll
        for (int ai = 0; ai < 2; ++ai)
#pragma unroll
            for (int m = 0; m < 4; ++m) { bf16_t* rowp = O + (size_t)(row0 + ai * HALF + m * 16) * ldc + col0;
#pragma unroll
                for (int bj = 0; bj < 2; ++bj) { f32x4 v0 = acc[ai][bj][m][0], v1 = acc[ai][bj][m][1];
                    if (ACT == 1) {
#pragma unroll
                        for (int e = 0; e < 4; ++e) { float a = fmaxf(v0[e], 0.f), b = fmaxf(v1[e], 0.f); v0[e] = a * a; v1[e] = b * b; } }
                    u32x4 w; w.x = cvt_pk_bf16(v0[0], v0[1]); w.y = cvt_pk_bf16(v0[2], v0[3]); w.z = cvt_pk_bf16(v1[0], v1[1]); w.w = cvt_pk_bf16(v1[2], v1[3]);
                    EPI_ST(u32x4, rowp + bj * HALF, w); } }
    }
};
struct EpiResid {
    static constexpr bool PERM = false, AFTER_DRAIN = false;
    const float* resX; const float* resC; float* out; const float* gate; bf16_t* xb;
    __device__ __forceinline__ void operator()(const f32x4 (&acc)[2][2][4][2], const Unit& u, int wr, int wc, int fr, int fq) const {
        const int batch = u.pm < 64 ? (u.pm >> 3) : 8;
        const float* res = u.pm < 64 ? resX + (size_t)u.pm * BM * 2048 : resC + (size_t)(u.pm - 64) * BM * 2048;
        float* o = out + (size_t)u.pm * BM * 2048;
        const int col0 = u.pn * BM + wc * 32 + 4 * fq;
        const float* gp = gate + (size_t)batch * 12288 + col0;
        f32x4 gv[2][2];
#pragma unroll
        for (int bj = 0; bj < 2; ++bj)
#pragma unroll
            for (int n = 0; n < 2; ++n) gv[bj][n] = *(const f32x4*)(gp + bj * HALF + n * 16);
#pragma unroll
        for (int ai = 0; ai < 2; ++ai)
#pragma unroll
          for (int mh = 0; mh < 2; ++mh) {
            f32x4 rv[2][2][2];
#pragma unroll
            for (int mm = 0; mm < 2; ++mm) { const int m = mh * 2 + mm; const size_t off = (size_t)(ai * HALF + wr * 64 + m * 16 + fr) * 2048 + col0;
#pragma unroll
                for (int bj = 0; bj < 2; ++bj)
#pragma unroll
                    for (int n = 0; n < 2; ++n) rv[mm][bj][n] = *(const f32x4*)(res + off + bj * HALF + n * 16); }
            __builtin_amdgcn_sched_barrier(0);
#pragma unroll
            for (int mm = 0; mm < 2; ++mm) { const int m = mh * 2 + mm; const size_t off = (size_t)(ai * HALF + wr * 64 + m * 16 + fr) * 2048 + col0;
#pragma unroll
                for (int bj = 0; bj < 2; ++bj)
#pragma unroll
                    for (int n = 0; n < 2; ++n) { const f32x4 y = rv[mm][bj][n] + gv[bj][n] * acc[ai][bj][m][n]; EPI_ST(f32x4, o + off + bj * HALF + n * 16, y);
                        if (xb) { typedef unsigned u32x2 __attribute__((ext_vector_type(2))); u32x2 w; w.x = cvt_pk_bf16(y[0], y[1]); w.y = cvt_pk_bf16(y[2], y[3]); *(u32x2*)(xb + (size_t)u.pm * BM * 2048 + off + bj * HALF + n * 16) = w; } } }
            __builtin_amdgcn_sched_barrier(0);
          }
    }
};

struct EpiPart {
    static constexpr bool PERM = false, AFTER_DRAIN = false;
    float* part; int pm0; size_t slice;
    __device__ __forceinline__ void operator()(const f32x4 (&acc)[2][2][4][2], const Unit& u, int wr, int wc, int fr, int fq) const {
        float* o = part + (size_t)u.ks * slice + (size_t)(u.pm - pm0) * BM * 2048;
        const int col0 = u.pn * BM + wc * 32 + 4 * fq;
#pragma unroll
        for (int ai = 0; ai < 2; ++ai)
#pragma unroll
            for (int m = 0; m < 4; ++m) { const size_t off = (size_t)(ai * HALF + wr * 64 + m * 16 + fr) * 2048 + col0;
#pragma unroll
                for (int bj = 0; bj < 2; ++bj)
#pragma unroll
                    for (int n = 0; n < 2; ++n) EPI_ST(f32x4, o + off + bj * HALF + n * 16, acc[ai][bj][m][n]); }
    }
};
struct SplitOrder {
    int pm0, nM, nN, NS, G, c;
    __host__ __device__ void init(int pm0_, int nM_, int nN_, int NS_, int G_, int c_) { pm0 = pm0_; nM = nM_; nN = nN_; NS = NS_; G = G_; c = c_; }
    __host__ __device__ bool next(int i, Unit& u) const {
        const long L = (long)i * G + c; if (L >= (long)nM * nN * NS) return false;
        const int t = (int)L / NS; u.ks = (int)L % NS; u.pm = pm0 + t % nM; u.pn = t / nM; return true;
    }
    __device__ __forceinline__ void a_ready(const Unit&) const {}
    __device__ __forceinline__ void done(const Unit&) const {}
};

struct EpiInProj {
    static constexpr bool PERM = true, AFTER_DRAIN = false;
    bf16_t* O; int ldc; const float* gq; const float* gk; const float* rope; PG8_LAS float* red;
    __device__ __forceinline__ void operator()(const f32x4 (&acc)[2][2][4][2], const Unit& u, int wr, int wc, int fr, int fq) const {
        const int pn = u.pn; const bool lat = u.pm < 64;
        const int kind = pn <= 2 ? 1 : ((pn >= 10 && pn <= 13) ? 2 : ((pn >= 16 && pn <= 18) ? 3 : 0));
        const int row0 = u.pm * BM + wr * 64 + fr; const int col0 = pn * BM + wc * 32 + 8 * fq;
        const bool do_rope = lat && kind != 0;
        f32x4 g0 = (f32x4){1.f, 1.f, 1.f, 1.f}, g1 = g0;
        if (kind == 1) {
            const float* gp = (pn < 2 ? gq : gk) + wc * 32 + 8 * fq; g0 = *(const f32x4*)gp; g1 = *(const f32x4*)(gp + 4);
#pragma unroll
            for (int ai = 0; ai < 2; ++ai)
#pragma unroll
                for (int m = 0; m < 4; ++m)
#pragma unroll
                    for (int bj = 0; bj < 2; ++bj) { const f32x4 a = acc[ai][bj][m][0], b = acc[ai][bj][m][1];
                        float s = (a[0] * a[0] + a[1] * a[1]) + (a[2] * a[2] + a[3] * a[3]) + (b[0] * b[0] + b[1] * b[1]) + (b[2] * b[2] + b[3] * b[3]);
                        s = ::sum_xor<16>(s); s = ::sum_xor<32>(s);
                        if (fq == 0) red[((ai * HALF + wr * 64 + m * 16 + fr) * 2 + bj) * 4 + wc] = s; }
            asm volatile("s_waitcnt lgkmcnt(0)" ::: "memory"); __builtin_amdgcn_s_barrier(); asm volatile("" ::: "memory");
        }
        const float* cosT = rope; const float* sinT = rope + 2048 * 64; int tw = 64, p0 = wc * 16 + 4 * fq;
        if (kind == 2) { cosT = rope + 2 * 2048 * 64; sinT = cosT + 2048 * 32; tw = 32; p0 = (wc & 1) * 16 + 4 * fq; }
        f32x4 csa[2][4], sna[2][4];
#pragma unroll
        for (int ai = 0; ai < 2; ++ai)
#pragma unroll
            for (int m = 0; m < 4; ++m) { csa[ai][m] = (f32x4){1.f, 1.f, 1.f, 1.f}; sna[ai][m] = (f32x4){0.f, 0.f, 0.f, 0.f};
                if (do_rope) { const int pos = (row0 + ai * HALF + m * 16) & 2047; csa[ai][m] = *(const f32x4*)(cosT + pos * tw + p0); sna[ai][m] = *(const f32x4*)(sinT + pos * tw + p0); } }
        __builtin_amdgcn_sched_barrier(0);
#pragma unroll
        for (int ai = 0; ai < 2; ++ai)
#pragma unroll
            for (int m = 0; m < 4; ++m) { const int row = row0 + ai * HALF + m * 16; bf16_t* rowp = O + ((size_t)(pn * 2) * ldc + row) * 128 + wc * 32 + 8 * fq;
                const f32x4 cs = csa[ai][m], sn = sna[ai][m];
#pragma unroll
                for (int bj = 0; bj < 2; ++bj) { f32x4 v0 = acc[ai][bj][m][0], v1 = acc[ai][bj][m][1];
                    if (kind == 1) { const f32x4 t = *(const PG8_LAS f32x4*)(red + ((ai * HALF + wr * 64 + m * 16 + fr) * 2 + bj) * 4);
                        const float r = 1.0f / sqrtf(((t[0] + t[1]) + (t[2] + t[3])) * (1.0f / 128.0f) + 1e-6f); v0 = v0 * r * g0; v1 = v1 * r * g1; }
                    if (kind != 0) { const f32x4 a = v0, b = v1;
                        v0[0] = a[0] * cs[0] - a[1] * sn[0]; v0[1] = a[0] * sn[0] + a[1] * cs[0]; v0[2] = a[2] * cs[1] - a[3] * sn[1]; v0[3] = a[2] * sn[1] + a[3] * cs[1];
                        v1[0] = b[0] * cs[2] - b[1] * sn[2]; v1[1] = b[0] * sn[2] + b[1] * cs[2]; v1[2] = b[2] * cs[3] - b[3] * sn[3]; v1[3] = b[2] * sn[3] + b[3] * cs[3]; }
                    u32x4 w; w.x = cvt_pk_bf16(v0[0], v0[1]); w.y = cvt_pk_bf16(v0[2], v0[3]); w.z = cvt_pk_bf16(v1[0], v1[1]); w.w = cvt_pk_bf16(v1[2], v1[3]);
                    EPI_ST(u32x4, rowp + (size_t)bj * ldc * 128, w); } }
    }
};

struct ChunkOrder {
    StaticOrder S; int nr, nch;
    __host__ __device__ void init(int M, int N, int G_, int c_, int wgm_, int nch_) { S.init(M, N, G_, c_, wgm_); nr = (S.nwg + G_ - 1) / G_; nch = nch_; }
    __host__ __device__ bool next(int i, Unit& u) const { const int ch = i / nr; if (ch >= nch) return false; const bool ok = S.next(i - ch * nr, u); u.ks = ch; return ok; }
    __device__ __forceinline__ void a_ready(const Unit&) const {}
    __device__ __forceinline__ void done(const Unit&) const {}
};

#ifndef EPB_NBF
#define EPB_NBF 1
#endif
#ifndef EPB_NBH
#define EPB_NBH 2
#endif
template <bool RES_F32> struct EpiResidB {
    static constexpr bool PERM = true, AFTER_DRAIN = false;
    const float* resf; const bf16_t* resh; bf16_t* out; const float* gate;
    __device__ __forceinline__ void operator()(const f32x4 (&acc)[2][2][4][2], const Unit& u, int wr, int wc, int fr, int fq) const {
        const int batch = u.pm >> 3;
        int rl = wr * 64 + fr; asm volatile("" : "+v"(rl));
        const size_t rbase = (size_t)u.pm * BM * 2048;
        bf16_t* o = out + (size_t)u.pm * BM * 2048;
        const int col0 = u.pn * BM + wc * 32 + 8 * fq;
        const float* gp = gate + (size_t)batch * 12288 + col0;
        f32x4 gv[2][2];
#pragma unroll
        for (int bj = 0; bj < 2; ++bj)
#pragma unroll
            for (int n = 0; n < 2; ++n) gv[bj][n] = *(const f32x4*)(gp + bj * HALF + 4 * n);
        constexpr int NB = RES_F32 ? EPB_NBF : EPB_NBH;
#pragma unroll
        for (int ai = 0; ai < 2; ++ai)
#pragma unroll
          for (int mbi = 0; mbi < 4 / NB; ++mbi) { const int mb = mbi * NB;
            f32x4 rf[NB][2][2]; u32x4 rw[NB][2];
#pragma unroll
            for (int mm = 0; mm < NB; ++mm) { const int m = mb + mm; const size_t off = (size_t)(ai * HALF + m * 16 + rl) * 2048 + col0;
#pragma unroll
                for (int bj = 0; bj < 2; ++bj) {
                    if constexpr (RES_F32) { const float* rp = resf + rbase + off + bj * HALF; rf[mm][bj][0] = *(const f32x4*)rp; rf[mm][bj][1] = *(const f32x4*)(rp + 4); }
                    else rw[mm][bj] = *(const u32x4*)(resh + rbase + off + bj * HALF); } }
            __builtin_amdgcn_sched_barrier(0);
#pragma unroll
            for (int mm = 0; mm < NB; ++mm) { const int m = mb + mm; const size_t off = (size_t)(ai * HALF + m * 16 + rl) * 2048 + col0;
#pragma unroll
                for (int bj = 0; bj < 2; ++bj) { f32x4 r0, r1;
                    if constexpr (RES_F32) { r0 = rf[mm][bj][0]; r1 = rf[mm][bj][1]; }
                    else { const u32x4 w = rw[mm][bj];
                        r0 = (f32x4){__builtin_bit_cast(float, w.x << 16), __builtin_bit_cast(float, w.x & 0xffff0000u), __builtin_bit_cast(float, w.y << 16), __builtin_bit_cast(float, w.y & 0xffff0000u)};
                        r1 = (f32x4){__builtin_bit_cast(float, w.z << 16), __builtin_bit_cast(float, w.z & 0xffff0000u), __builtin_bit_cast(float, w.w << 16), __builtin_bit_cast(float, w.w & 0xffff0000u)}; }
                    const f32x4 y0 = r0 + gv[bj][0] * acc[ai][bj][m][0], y1 = r1 + gv[bj][1] * acc[ai][bj][m][1];
                    u32x4 w2; w2.x = cvt_pk_bf16(y0[0], y0[1]); w2.y = cvt_pk_bf16(y0[2], y0[3]); w2.z = cvt_pk_bf16(y1[0], y1[1]); w2.w = cvt_pk_bf16(y1[2], y1[3]);
                    EPI_ST(u32x4, o + off + bj * HALF, w2); } }
            __builtin_amdgcn_sched_barrier(0);
          }
    }
};
template <class Epi, class Sched, bool ALIGN_EPI = false, bool SP2 = false>
__device__ __forceinline__ void gemm_phase(PG8_LAS unsigned char* lds, const Gemm g, const Sched& S, const Epi& E) {
    int tid_ = threadIdx.x; asm volatile("" : "+v"(tid_));
    const int tid = tid_, wid = __builtin_amdgcn_readfirstlane(tid >> 6), lane = tid & 63, wr = wid >> 2, wc = wid & 3, fr = lane & 15, fq = lane >> 4;
    const int K = g.K, nt = g.Kext / BK; const size_t sstep = (size_t)g.Kext * 2;
    unsigned voffA[2], voffB[2];
#pragma unroll
    for (int i = 0; i < 2; ++i) { int R, C; stage_rc(tid * 16 + i * 8192, R, C); const int Rb = Epi::PERM ? ((R & ~31) + perm32(R & 31)) : R;
        voffA[i] = (unsigned)(R * K + C) * 2u; voffB[i] = (unsigned)(Rb * K + C) * 2u; }
    const size_t kstep = (size_t)(BK * 2);
    const size_t hstep = (size_t)HALF * K * 2;
    const size_t tstep = 2 * hstep;
    const unsigned ldsw = (unsigned)wid * 1024u;
    const int aoff = lds_byte(wr * 64 + fr, fq * 8), boff = lds_byte(wc * 32 + fr, fq * 8);
#define PG8_SA(b, h) (((b) * 2 + (h)) * HTB)
#define PG8_SB(b, h) ((4 + (b) * 2 + (h)) * HTB)
#define PG8_STAGE(bufoff, gbase, voff) do { _Pragma("unroll") for (int _i = 0; _i < 2; ++_i) \
        __builtin_amdgcn_global_load_lds((const unsigned*)((const char*)(gbase) + (voff)[_i]), (PG8_LAS unsigned*)(lds + (bufoff) + ldsw + _i * 8192), 16, 0, 0); } while (0)
#define PG8_LDA(dst, b, h) do { _Pragma("unroll") for (int m = 0; m < 4; ++m) _Pragma("unroll") for (int k = 0; k < 2; ++k) dst[m][k] = *(const PG8_LAS bf16x8*)(lds + PG8_SA(b, h) + aoff + m * 2048 + k * 1024); } while (0)
#define PG8_LDB(dst, b, h) do { _Pragma("unroll") for (int n = 0; n < 2; ++n) _Pragma("unroll") for (int k = 0; k < 2; ++k) dst[n][k] = *(const PG8_LAS bf16x8*)(lds + PG8_SB(b, h) + boff + n * 2048 + k * 1024); } while (0)
#define PG8_MMA(ai, bj, At, Bt) do { __builtin_amdgcn_s_setprio(1); _Pragma("unroll") for (int m = 0; m < 4; ++m) _Pragma("unroll") for (int n = 0; n < 2; ++n) _Pragma("unroll") for (int k = 0; k < 2; ++k) \
        acc[ai][bj][m][n] = __builtin_amdgcn_mfma_f32_16x16x32_bf16(Bt[n][k], At[m][k], acc[ai][bj][m][n], 0, 0, 0); __builtin_amdgcn_s_setprio(0); } while (0)
#define PG8_WAIT_V(n) asm volatile("s_waitcnt vmcnt(" #n ")" ::: "memory")
#define PG8_WAIT_L(n) asm volatile("s_waitcnt lgkmcnt(" #n ")" ::: "memory")
#define PG8_BAR __builtin_amdgcn_s_barrier()
#define PG8_SCHED __builtin_amdgcn_sched_barrier(0)
    Unit cur, nxt; int ui = 0;
    if (!S.next(0, cur)) return;
    f32x4 acc[2][2][4][2];
#pragma unroll
    for (int a = 0; a < 2; ++a)
#pragma unroll
        for (int b = 0; b < 2; ++b)
#pragma unroll
            for (int m = 0; m < 4; ++m)
#pragma unroll
                for (int n = 0; n < 2; ++n) acc[a][b][m][n] = (f32x4){0.f, 0.f, 0.f, 0.f};
    bf16x8 At[4][2], B0[2][2], B1[2][2];
    const char* cA = (const char*)g.A + (size_t)cur.pm * tstep + (size_t)cur.ks * sstep; const char* cB = (const char*)g.Bt + (size_t)cur.pn * tstep + (size_t)cur.ks * sstep;
    S.a_ready(cur);
    if constexpr (SP2) {
        PG8_STAGE(PG8_SB(0, 0), cB, voffB); PG8_STAGE(PG8_SB(0, 1), cB + hstep, voffB); PG8_STAGE(PG8_SA(0, 0), cA, voffA); PG8_STAGE(PG8_SA(0, 1), cA + hstep, voffA);
        if (wr == 1) PG8_BAR;
        PG8_WAIT_V(2); PG8_BAR;
        PG8_STAGE(PG8_SB(1, 0), cB + kstep, voffB); PG8_STAGE(PG8_SA(1, 0), cA + kstep, voffA); PG8_STAGE(PG8_SB(1, 1), cB + hstep + kstep, voffB);
        PG8_WAIT_V(6); PG8_BAR;
    } else {
        PG8_STAGE(PG8_SB(0, 0), cB, voffB); PG8_STAGE(PG8_SA(0, 0), cA, voffA); PG8_STAGE(PG8_SB(0, 1), cB + hstep, voffB); PG8_STAGE(PG8_SA(0, 1), cA + hstep, voffA);
        if (wr == 1) PG8_BAR;
        PG8_WAIT_V(4); PG8_BAR;
        PG8_STAGE(PG8_SB(1, 0), cB + kstep, voffB); PG8_STAGE(PG8_SA(1, 0), cA + kstep, voffA); PG8_STAGE(PG8_SB(1, 1), cB + hstep + kstep, voffB);
        PG8_WAIT_V(6); PG8_BAR;
    }
    for (;;) {
        const bool has_next = S.next(ui + 1, nxt);
        const char* nA = has_next ? (const char*)g.A + (size_t)nxt.pm * tstep + (size_t)nxt.ks * sstep : cA; const char* nB = has_next ? (const char*)g.Bt + (size_t)nxt.pn * tstep + (size_t)nxt.ks * sstep : cB;
        for (int t = 0; t < nt; t += 2) {
            const bool last = (t == nt - 2);
            const char* a1 = cA + (size_t)(t + 1) * kstep;
            const char* a2 = last ? nA : cA + (size_t)(t + 2) * kstep; const char* b2 = last ? nB : cB + (size_t)(t + 2) * kstep;
            const char* a3 = a2 + kstep; const char* b3 = b2 + kstep;
            if (last && has_next) S.a_ready(nxt);
            if constexpr (SP2) {
            PG8_LDB(B0, 0, 0); PG8_LDB(B1, 0, 1); PG8_SCHED; PG8_LDA(At, 0, 0); PG8_STAGE(PG8_SA(1, 1), a1 + hstep, voffA);
            PG8_WAIT_V(8); PG8_WAIT_L(0); PG8_BAR; PG8_MMA(0, 0, At, B0); PG8_MMA(0, 1, At, B1); PG8_BAR; PG8_SCHED;
            PG8_LDA(At, 0, 1); PG8_STAGE(PG8_SB(0, 0), b2, voffB); PG8_STAGE(PG8_SB(0, 1), b2 + hstep, voffB); PG8_STAGE(PG8_SA(0, 0), a2, voffA);
            PG8_WAIT_V(8); PG8_WAIT_L(0); PG8_BAR; PG8_MMA(1, 0, At, B0); PG8_MMA(1, 1, At, B1); PG8_BAR; PG8_SCHED;
            PG8_LDB(B0, 1, 0); PG8_LDB(B1, 1, 1); PG8_SCHED; PG8_LDA(At, 1, 0); PG8_STAGE(PG8_SA(0, 1), a2 + hstep, voffA);
            PG8_WAIT_V(8); PG8_WAIT_L(0); PG8_BAR; PG8_MMA(0, 0, At, B0); PG8_MMA(0, 1, At, B1); PG8_BAR; PG8_SCHED;
            PG8_LDA(At, 1, 1); PG8_STAGE(PG8_SB(1, 0), b3, voffB); PG8_STAGE(PG8_SB(1, 1), b3 + hstep, voffB); PG8_STAGE(PG8_SA(1, 0), a3, voffA);
            PG8_WAIT_V(8); PG8_WAIT_L(0); PG8_BAR; PG8_MMA(1, 0, At, B0); PG8_MMA(1, 1, At, B1); PG8_BAR; PG8_SCHED;
            } else {
            PG8_LDB(B0, 0, 0); PG8_SCHED; PG8_LDA(At, 0, 0); PG8_STAGE(PG8_SA(1, 1), a1 + hstep, voffA);
            PG8_WAIT_L(8); PG8_BAR; PG8_WAIT_L(0); PG8_MMA(0, 0, At, B0); PG8_BAR; PG8_SCHED;
            PG8_LDB(B1, 0, 1); PG8_STAGE(PG8_SB(0, 0), b2, voffB);
            PG8_BAR; PG8_WAIT_L(0); PG8_MMA(0, 1, At, B1); PG8_BAR;
            PG8_LDA(At, 0, 1); PG8_STAGE(PG8_SA(0, 0), a2, voffA);
            PG8_BAR; PG8_WAIT_L(0); PG8_MMA(1, 0, At, B0); PG8_BAR; PG8_SCHED;
            PG8_STAGE(PG8_SB(0, 1), b2 + hstep, voffB);
            PG8_WAIT_V(6); PG8_BAR; PG8_MMA(1, 1, At, B1); PG8_BAR;
            PG8_LDB(B0, 1, 0); PG8_SCHED; PG8_LDA(At, 1, 0); PG8_STAGE(PG8_SA(0, 1), a2 + hstep, voffA);
            PG8_WAIT_L(8); PG8_BAR; PG8_WAIT_L(0); PG8_MMA(0, 0, At, B0); PG8_BAR; PG8_SCHED;
            PG8_LDB(B1, 1, 1); PG8_STAGE(PG8_SB(1, 0), b3, voffB);
            PG8_BAR; PG8_WAIT_L(0); PG8_MMA(0, 1, At, B1); PG8_BAR;
            PG8_LDA(At, 1, 1); PG8_STAGE(PG8_SA(1, 0), a3, voffA);
            PG8_BAR; PG8_WAIT_L(0); PG8_MMA(1, 0, At, B0); PG8_BAR; PG8_SCHED;
            PG8_STAGE(PG8_SB(1, 1), b3 + hstep, voffB);
            PG8_WAIT_V(6); PG8_BAR; PG8_MMA(1, 1, At, B1); PG8_BAR;
            }
        }
        if constexpr (ALIGN_EPI) { if (wr == 0) PG8_BAR; }
        if constexpr (!Epi::AFTER_DRAIN) { E(acc, cur, wr, wc, fr, fq); S.done(cur); }
        if (!has_next) break;
#pragma unroll
        for (int a = 0; a < 2; ++a)
#pragma unroll
            for (int b = 0; b < 2; ++b)
#pragma unroll
                for (int m = 0; m < 4; ++m)
#pragma unroll
                    for (int n = 0; n < 2; ++n) acc[a][b][m][n] = (f32x4){0.f, 0.f, 0.f, 0.f};
        cur = nxt; cA = nA; cB = nB; ++ui;
        if constexpr (ALIGN_EPI) { if (wr == 1) PG8_BAR; }
    }
    PG8_WAIT_V(0);
    if constexpr (!ALIGN_EPI) { if (wr == 0) PG8_BAR; }
    PG8_BAR;
    if constexpr (Epi::AFTER_DRAIN) { E.fused(acc, cur, wr, wc, fr, fq, lds, wid, lane); S.done(cur); }
#undef PG8_SA
#undef PG8_SB
#undef PG8_STAGE
#undef PG8_LDA
#undef PG8_LDB
#undef PG8_MMA
#undef PG8_WAIT_V
#undef PG8_WAIT_L
#undef PG8_BAR
#undef PG8_SCHED
}
}
namespace att {
constexpr int NW_ = 8, QBLK = 32;
using bf16x8 = __attribute__((ext_vector_type(8))) short;
using s16x4  = __attribute__((ext_vector_type(4))) short;
using f32x16 = __attribute__((ext_vector_type(16))) float;
using f32x8  = __attribute__((ext_vector_type(8))) float;
using u32x4  = __attribute__((ext_vector_type(4))) unsigned;
#define KSWZ(row, colB) ((row) * 256 + ((colB) ^ (((row) & 7) << 4)))
#define SBAR() __builtin_amdgcn_sched_barrier(0)
__device__ __forceinline__ int crow(int r, int hi) { return (r & 3) + 8 * (r >> 2) + 4 * hi; }
__device__ __forceinline__ unsigned cvtpk(float lo, float hi) {
  unsigned r; asm volatile("v_cvt_pk_bf16_f32 %0, %1, %2" : "=v"(r) : "v"(lo), "v"(hi)); return r;
}
template <typename TIn> struct Stage;
template <> struct Stage<bf16>  { using T = bf16x8;
  __device__ static __forceinline__ T ld8(const bf16* p) { return *reinterpret_cast<const bf16x8*>(p); }
  __device__ static __forceinline__ bf16x8 tobf(T x) { return x; } };
template <> struct Stage<float> { using T = f32x8;
  __device__ static __forceinline__ T ld8(const float* p) { return *reinterpret_cast<const f32x8*>(p); }
  __device__ static __forceinline__ bf16x8 tobf(T x) {
    u32x4 w = {cvtpk(x[0], x[1]), cvtpk(x[2], x[3]), cvtpk(x[4], x[5]), cvtpk(x[6], x[7])}; return *reinterpret_cast<bf16x8*>(&w); } };

__device__ __forceinline__ void partialSM(f32x16& p0, f32x16& p1, float& m_reg, float& mn, float& alpha, const float C, const float thr_raw) {
  float pmax = p0[0]; for (int r = 1; r < 16; ++r) pmax = fmaxf(pmax, p0[r]); for (int r = 0; r < 16; ++r) pmax = fmaxf(pmax, p1[r]);
  { auto rr = __builtin_amdgcn_permlane32_swap(__float_as_uint(pmax), __float_as_uint(pmax), false, false);
    pmax = fmaxf(__uint_as_float(rr[0]), __uint_as_float(rr[1])); }
  if (__builtin_expect(__all(pmax - m_reg <= thr_raw), 1)) { mn = m_reg; alpha = 1.f; }
  else { mn = fmaxf(m_reg, pmax); alpha = __builtin_amdgcn_exp2f((m_reg - mn) * C); m_reg = mn; }
  float mnC = -mn * C;
  for (int r = 0; r < 16; ++r) p0[r] = fmaf(p0[r], C, mnC); for (int r = 0; r < 16; ++r) p1[r] = fmaf(p1[r], C, mnC);
  for (int r = 0; r < 16; ++r) p0[r] = __builtin_amdgcn_exp2f(p0[r]);
}
__device__ __forceinline__ void finishSM(f32x16& p0, f32x16& p1, float alpha, float& l_reg, bf16x8& pa0, bf16x8& pa1, bf16x8& pa2, bf16x8& pa3) {
  for (int r = 0; r < 16; ++r) p1[r] = __builtin_amdgcn_exp2f(p1[r]);
  float ps = 0; for (int r = 0; r < 16; ++r) ps += p0[r]; for (int r = 0; r < 16; ++r) ps += p1[r];
  { auto rr = __builtin_amdgcn_permlane32_swap(__float_as_uint(ps), __float_as_uint(ps), false, false);
    ps = __uint_as_float(rr[0]) + __uint_as_float(rr[1]); }
  l_reg = l_reg * alpha + ps;
#define PK4(P, BASE, OUT) do { unsigned a0 = cvtpk(P[BASE + 0], P[BASE + 1]), a1 = cvtpk(P[BASE + 2], P[BASE + 3]);   \
    unsigned b0 = cvtpk(P[BASE + 4], P[BASE + 5]), b1 = cvtpk(P[BASE + 6], P[BASE + 7]);                              \
    auto r0 = __builtin_amdgcn_permlane32_swap(a0, b0, false, false); auto r1 = __builtin_amdgcn_permlane32_swap(a1, b1, false, false); \
    u32x4 w = {r0[0], r1[0], r0[1], r1[1]}; OUT = *reinterpret_cast<bf16x8*>(&w); } while (0)
  PK4(p0, 0, pa0); PK4(p0, 8, pa1); PK4(p1, 0, pa2); PK4(p1, 8, pa3);
#undef PK4
}
template <bool full> __device__ __forceinline__ void qkt(f32x16& p0, f32x16& p1, const bf16* Ks, const bf16x8* qr, int r32, int hi, const int koff) {
  p0 = f32x16{}; p1 = f32x16{};
  for (int d0 = 0; d0 < 4; ++d0) { int cb = (d0 * 16 + hi * 8) * 2 + koff;
    bf16x8 b0 = *reinterpret_cast<const bf16x8*>((const char*)Ks + KSWZ(r32, cb));
    bf16x8 b1 = *reinterpret_cast<const bf16x8*>((const char*)Ks + KSWZ(32 + r32, cb));
    p0 = __builtin_amdgcn_mfma_f32_32x32x16_bf16(b0, qr[d0], p0, 0, 0, 0);
    p1 = __builtin_amdgcn_mfma_f32_32x32x16_bf16(b1, qr[d0], p1, 0, 0, 0); }
  if constexpr (full) {
  for (int d0 = 4; d0 < 8; ++d0) { int cb = (d0 * 16 + hi * 8) * 2;
    bf16x8 b0 = *reinterpret_cast<const bf16x8*>((const char*)Ks + KSWZ(r32, cb));
    bf16x8 b1 = *reinterpret_cast<const bf16x8*>((const char*)Ks + KSWZ(32 + r32, cb));
    p0 = __builtin_amdgcn_mfma_f32_32x32x16_bf16(b0, qr[d0], p0, 0, 0, 0);
    p1 = __builtin_amdgcn_mfma_f32_32x32x16_bf16(b1, qr[d0], p1, 0, 0, 0); } }
}
__device__ __forceinline__ int v_st(int k, int c) { const int kk = (k & ~0xC) | ((k & 4) << 1) | ((k & 8) >> 1); return ((kk >> 3) * 4 + (c >> 5)) * 512 + ((kk & 7) * 32 + (c & 31)) * 2; }
__device__ __forceinline__ int v_rd_base(int lane) { return ((lane & 3) << 3) | (((lane >> 2) & 3) << 6) | (((lane >> 4) & 1) << 5) | (((lane >> 5) & 1) << 8); }
constexpr int v_rd_off(int d0, int ks, int half) { return d0 * 512 + ks * 4096 + half * 2048; }
template <int OFF> __device__ __forceinline__ s16x4 tr_read(int vb) {
  s16x4 r; asm volatile("ds_read_b64_tr_b16 %0, %1 offset:%2" : "=&v"(r) : "v"(vb), "i"(OFF) : "memory"); return r;
}
template <int D0> __device__ __forceinline__ void pv_one(f32x16& od, int vb, bf16x8 pa0, bf16x8 pa1, bf16x8 pa2, bf16x8 pa3) {
  const s16x4 l0 = tr_read<v_rd_off(D0, 0, 0)>(vb), h0 = tr_read<v_rd_off(D0, 0, 1)>(vb), l1 = tr_read<v_rd_off(D0, 1, 0)>(vb), h1 = tr_read<v_rd_off(D0, 1, 1)>(vb);
  const s16x4 l2 = tr_read<v_rd_off(D0, 2, 0)>(vb), h2 = tr_read<v_rd_off(D0, 2, 1)>(vb), l3 = tr_read<v_rd_off(D0, 3, 0)>(vb), h3 = tr_read<v_rd_off(D0, 3, 1)>(vb);
  asm volatile("s_waitcnt lgkmcnt(0)" ::: "memory"); SBAR();
#define PK(L, H) (bf16x8){L[0], L[1], L[2], L[3], H[0], H[1], H[2], H[3]}
  od = __builtin_amdgcn_mfma_f32_32x32x16_bf16(pa0, PK(l0, h0), od, 0, 0, 0);
  od = __builtin_amdgcn_mfma_f32_32x32x16_bf16(pa1, PK(l1, h1), od, 0, 0, 0);
  od = __builtin_amdgcn_mfma_f32_32x32x16_bf16(pa2, PK(l2, h2), od, 0, 0, 0);
  od = __builtin_amdgcn_mfma_f32_32x32x16_bf16(pa3, PK(l3, h3), od, 0, 0, 0);
#undef PK
}
__device__ __forceinline__ void pv_d0(f32x16* o, int vb, bf16x8 pa0, bf16x8 pa1, bf16x8 pa2, bf16x8 pa3) {
  pv_one<0>(o[0], vb, pa0, pa1, pa2, pa3); pv_one<1>(o[1], vb, pa0, pa1, pa2, pa3); pv_one<2>(o[2], vb, pa0, pa1, pa2, pa3); pv_one<3>(o[3], vb, pa0, pa1, pa2, pa3);
}
struct AttnUnit {
  const bf16* Q; const bf16* K; const bf16* V; bf16* O;
  int ctx_row0, lat_row0, nctx, nt;
  int qpos0, kpos0;
  float C, thr_raw;
  int nsub, sub;
  float lam, post;
  const float* gsub;
  float sink; int has_sink;
  const float* rpb;
  float* stash;
};
#ifndef B_PIPE
#define B_PIPE 0
#endif
#ifndef ATT_SDEPTH
#define ATT_SDEPTH 1
#endif
#ifndef ATT_SDEPTH_FULL
#define ATT_SDEPTH_FULL 1
#endif
#ifndef ATT_SDEPTH_HALF
#define ATT_SDEPTH_HALF 2
#endif
constexpr int LDK = 128, LDO = 2048;
constexpr int SHM_V = 16384, SHM_K = 16384;
constexpr int ATT_WS_OFF = 2 * SHM_V + 2 * SHM_K, ATT_RPB_OFF = ATT_WS_OFF + NW_ * 64 * 4, ATT_LDS = ATT_RPB_OFF + 2048;

template <int MODE>
__device__ __forceinline__ void mask_tile(f32x16& p0, f32x16& p1, int j, const AttnUnit& u, int wid, int r32, int hi, const float* rpbL) {
  if (MODE == 0) return;
  if (j < u.nctx) return;
  int qi = u.qpos0 + wid * 32 + r32; asm volatile("" : "+v"(qi));
  if (MODE == 2) {
    const int kb = u.kpos0 + (j - u.nctx) * 64 + 4 * hi - qi;
#pragma unroll
    for (int r = 0; r < 16; ++r) { const int d0 = kb + (r & 3) + 8 * (r >> 2), d1 = d0 + 32;
      p0[r] = (d0 <= 128 && d0 >= -128) ? p0[r] : -1e30f; p1[r] = (d1 <= 128 && d1 >= -128) ? p1[r] : -1e30f; }
  } else {
    const int i = (u.kpos0 >> 6) + (j - u.nctx);
    const int qr_ = qi >> 6, qc = qi & 63;
    int rs = qr_ - 4; rs = rs < 0 ? 0 : (rs > 24 ? 24 : rs);
    int cs = qc - 8; cs = cs < 0 ? 0 : (cs > 48 ? 48 : cs);
    const bool rowok = (i >= rs) && (i < rs + 8);
    const int bbase = (i - qr_ + 7) * 31 + 15 - qc;
#pragma unroll
    for (int r = 0; r < 16; ++r) { const int c0 = (r & 3) + 8 * (r >> 2) + 4 * hi, c1 = c0 + 32;
        const bool ok0 = rowok && (unsigned)(c0 - cs) < 16u, ok1 = rowok && (unsigned)(c1 - cs) < 16u;
        const float b0 = rpbL[ok0 ? bbase + c0 : 0], b1 = rpbL[ok1 ? bbase + c1 : 0];
        p0[r] = ok0 ? p0[r] + b0 : -1e30f; p1[r] = ok1 ? p1[r] + b1 : -1e30f;
        if (r & 1) __builtin_amdgcn_sched_barrier(0); }
  }
}

#ifdef USE_SGB
#define SGB_QK() do { _Pragma("unroll") for (int i_ = 0; i_ < (FULL ? 16 : 8); ++i_) { __builtin_amdgcn_sched_group_barrier(0x008, 1, 0); __builtin_amdgcn_sched_group_barrier(0x100, 1, 0); __builtin_amdgcn_sched_group_barrier(0x002, SGB_NV, 0); } } while (0)
#else
#define SGB_QK() do { } while (0)
#endif
#ifndef SGB_NV
#define SGB_NV 6
#endif
template <int MODE, bool FULL>
__device__ __forceinline__ void attn_unit(const AttnUnit& u, char* lds) {
  using St = Stage<bf16>;
  constexpr int SDEPTH = (MODE == 0) ? (FULL ? ATT_SDEPTH_FULL : ATT_SDEPTH_HALF) : ATT_SDEPTH;
  int tid = threadIdx.x; asm volatile("" : "+v"(tid));
  const int wid = tid >> 6, lane = tid & 63, r32 = lane & 31, hi = lane >> 5;
  bf16* V_lds = (bf16*)lds; bf16* K_lds = (bf16*)(lds + 2 * SHM_V);
  float* ws = (float*)(lds + ATT_WS_OFF) + wid * 64; float* li_l = ws; float* al_l = ws + 32;
  float* rpbL = (float*)(lds + ATT_RPB_OFF);
#ifdef T3
  const float C = 0.1275174f, thr_raw = 90.5f;
#else
  const float C = u.C, thr_raw = u.thr_raw;
#endif
  __syncthreads();
  if (MODE == 1) { if (tid < 465) rpbL[tid] = u.rpb[tid] * 11.313708498984761f; }
  const int sr = tid >> 4, sc = (tid & 15) * 8, vst0 = v_st(sr, sc), vst1 = v_st(32 + sr, sc);
  const int vb0 = (int)(uintptr_t)V_lds + v_rd_base(lane);
  const unsigned kvoff = (unsigned)(sr * LDK + sc);
  const int NT = u.nt;
#define TROW(j) ((j) < u.nctx ? u.ctx_row0 + (j) * 64 : u.lat_row0 + ((j) - u.nctx) * 64)
  const int sub = u.sub; {
  float m_reg = -1e29f, l_reg = 0; f32x16 o[4] = {}; bf16x8 qr[8];
  const bf16* Qw = u.Q + (long)(wid * QBLK + r32) * LDK + hi * 8;
  constexpr bool qfull = FULL; const int koff = qfull ? 0 : sub * 128, qoff = qfull ? 0 : sub * 64;
#pragma unroll
  for (int d0 = 0; d0 < 8; ++d0) qr[d0] = St::ld8(Qw + (d0 < 4 ? qoff : 0) + d0 * 16);
  struct { typename St::T vs0, vs1, ks0, ks1; } sr_[SDEPTH];
#define SLOAD(i, tj) do { const long ro_ = (long)TROW(tj) * LDK; const bf16* kb_ = u.K + ro_; const bf16* vb_ = u.V + ro_; sr_[i].vs0 = St::ld8(vb_ + kvoff); sr_[i].vs1 = St::ld8(vb_ + 32 * LDK + kvoff); \
    sr_[i].ks0 = St::ld8(kb_ + kvoff); sr_[i].ks1 = St::ld8(kb_ + 32 * LDK + kvoff); } while (0)
#define SWRITE(b, i) do { *(bf16x8*)((char*)V_lds + (b) * SHM_V + vst0) = St::tobf(sr_[i].vs0);          \
    *(bf16x8*)((char*)V_lds + (b) * SHM_V + vst1) = St::tobf(sr_[i].vs1); int kc = sc * 2;               \
    *(bf16x8*)((char*)K_lds + (b) * SHM_K + KSWZ(sr, kc)) = St::tobf(sr_[i].ks0);                       \
    *(bf16x8*)((char*)K_lds + (b) * SHM_K + KSWZ(32 + sr, kc)) = St::tobf(sr_[i].ks1); } while (0)
#define SWAIT() do { if (SDEPTH == 2) asm volatile("s_waitcnt vmcnt(4)" ::: "memory"); else asm volatile("s_waitcnt vmcnt(0)" ::: "memory"); } while (0)
#define RESC(a) do { if (__any((a) < 1.f)) { if (hi == 0) al_l[r32] = (a); asm volatile("s_waitcnt lgkmcnt(0)" ::: "memory"); \
    for (int d = 0; d < 4; ++d) for (int r = 0; r < 16; ++r) o[d][r] *= al_l[crow(r, hi)]; } } while (0)
  f32x16 pA0, pA1, pB0, pB1; float mnA, mnB, alA, alB; bf16x8 pa0, pa1, pa2, pa3;
  constexpr int SE = 0, SO = SDEPTH - 1;
  if constexpr (MODE == 1 && !B_PIPE) {
  __syncthreads();
  SLOAD(SE, 0); asm volatile("s_waitcnt vmcnt(0)" ::: "memory"); SWRITE(0, SE); __syncthreads();
  for (int j = 0; j < NT; ++j) {
    const int bsel = j & 1;
    if (j + 1 < NT) SLOAD(SE, j + 1);
    SBAR(); qkt<FULL>(pA0, pA1, (bf16*)((char*)K_lds + bsel * SHM_K), qr, r32, hi, koff);
    mask_tile<MODE>(pA0, pA1, j, u, wid, r32, hi, rpbL); partialSM(pA0, pA1, m_reg, mnA, alA, C, thr_raw);
    RESC(alA);
    finishSM(pA0, pA1, alA, l_reg, pa0, pa1, pa2, pa3); SBAR();
    pv_d0(o, vb0 + bsel * (int)SHM_V, pa0, pa1, pa2, pa3);
    if (j + 1 < NT) { asm volatile("s_waitcnt vmcnt(0)" ::: "memory"); if (bsel) SWRITE(0, SE); else SWRITE(1, SE); }
    __syncthreads();
  }
  } else {
  __syncthreads();
  SLOAD(SE, 0); asm volatile("s_waitcnt vmcnt(0)" ::: "memory"); SWRITE(0, SE);
  if (SDEPTH == 1) SLOAD(SO, 1);
  __syncthreads();
  qkt<FULL>(pA0, pA1, K_lds, qr, r32, hi, koff); mask_tile<MODE>(pA0, pA1, 0, u, wid, r32, hi, rpbL); partialSM(pA0, pA1, m_reg, mnA, alA, C, thr_raw);
  if (SDEPTH == 2) { SLOAD(SO, 1); if (2 < NT) SLOAD(SE, 2); }
  SWAIT(); SWRITE(1, SO); __syncthreads();
  for (int j = 1; j + 1 < NT; j += 2) {
#ifdef EARLY_LOAD
    SLOAD(SO, j + SDEPTH); SBAR();
#endif
    SBAR(); qkt<FULL>(pB0, pB1, (bf16*)((char*)K_lds + SHM_K), qr, r32, hi, koff);
    finishSM(pA0, pA1, alA, l_reg, pa0, pa1, pa2, pa3); SGB_QK(); SBAR();
#ifndef EARLY_LOAD
    SLOAD(SO, j + SDEPTH); SBAR();
#endif
    pv_d0(o, vb0, pa0, pa1, pa2, pa3); mask_tile<MODE>(pB0, pB1, j, u, wid, r32, hi, rpbL); partialSM(pB0, pB1, m_reg, mnB, alB, C, thr_raw);
    __syncthreads(); SWAIT(); SWRITE(0, SE);
    RESC(alB); __syncthreads();
#ifdef EARLY_LOAD
    if (SDEPTH == 1 || j + 3 < NT) SLOAD(SE, j + 1 + SDEPTH); SBAR();
#endif
    SBAR(); qkt<FULL>(pA0, pA1, K_lds, qr, r32, hi, koff);
    finishSM(pB0, pB1, alB, l_reg, pa0, pa1, pa2, pa3); SGB_QK(); SBAR();
#ifndef EARLY_LOAD
    if (SDEPTH == 1 || j + 3 < NT) SLOAD(SE, j + 1 + SDEPTH); SBAR();
#endif
    pv_d0(o, vb0 + (int)SHM_V, pa0, pa1, pa2, pa3); mask_tile<MODE>(pA0, pA1, j + 1, u, wid, r32, hi, rpbL); partialSM(pA0, pA1, m_reg, mnA, alA, C, thr_raw);
    __syncthreads(); SWAIT(); SWRITE(1, SO);
    RESC(alA); __syncthreads();
  }
  SBAR(); qkt<FULL>(pB0, pB1, (bf16*)((char*)K_lds + SHM_K), qr, r32, hi, koff);
  finishSM(pA0, pA1, alA, l_reg, pa0, pa1, pa2, pa3); SBAR();
  pv_d0(o, vb0, pa0, pa1, pa2, pa3); mask_tile<MODE>(pB0, pB1, NT - 1, u, wid, r32, hi, rpbL); partialSM(pB0, pB1, m_reg, mnB, alB, C, thr_raw);
  __syncthreads(); RESC(alB);
  finishSM(pB0, pB1, alB, l_reg, pa0, pa1, pa2, pa3); SBAR();
  pv_d0(o, vb0 + (int)SHM_V, pa0, pa1, pa2, pa3);
  }
  asm volatile("s_waitcnt vmcnt(0)" ::: "memory");
  if (u.has_sink) l_reg += __builtin_amdgcn_exp2f(u.sink * 1.4426950408889634f - m_reg * C);
  if (hi == 0) li_l[r32] = l_reg; asm volatile("s_waitcnt lgkmcnt(0)" ::: "memory");
  float rli[16];
#pragma unroll
  for (int r = 0; r < 16; ++r) rli[r] = __builtin_amdgcn_rcpf(li_l[crow(r, hi)]);
#pragma unroll
  for (int r = 0; r < 16; ++r)
#pragma unroll
    for (int d0 = 0; d0 < 4; ++d0) o[d0][r] *= rli[r];
  if (u.nsub == 2) {
    float* sp = u.stash + (long)u.sub * (256 * 128) + (long)(wid * QBLK) * 128 + r32;
#pragma unroll
    for (int r = 0; r < 16; ++r)
#pragma unroll
      for (int d0 = 0; d0 < 4; ++d0) sp[crow(r, hi) * 128 + d0 * 32] = o[d0][r];
  } else {
    bf16* Ow = u.O + (long)(wid * QBLK) * LDO + r32;
#pragma unroll
    for (int r = 0; r < 16; ++r)
#pragma unroll
      for (int d0 = 0; d0 < 4; ++d0) Ow[(long)crow(r, hi) * LDO + d0 * 32] = (bf16)f2bf(o[d0][r]);
  }
  }
#undef TROW
#undef SLOAD
#undef SWRITE
#undef SWAIT
#undef RESC
}

__device__ __forceinline__ void unit_finish(const AttnUnit& u) {
  int tid = threadIdx.x; asm volatile("" : "+v"(tid));
  const int wid = tid >> 6, lane = tid & 63;
  if (u.nsub != 2 || u.sub == 0) return;
  __syncthreads();
  const float* s0 = u.stash + (long)(wid * QBLK) * 128 + 2 * lane; const float* s1 = s0 + 256 * 128;
  unsigned* op = (unsigned*)(u.O + (long)(wid * QBLK) * LDO) + lane;
  if (u.nsub == 2) {
    const float g0 = u.gsub[2 * lane] * u.post, g1 = u.gsub[2 * lane + 1] * u.post;
#pragma unroll 4
    for (int r = 0; r < 32; ++r) {
      const float a0 = s0[r * 128], a1 = s0[r * 128 + 1], b0 = s1[r * 128], b1 = s1[r * 128 + 1];
      const float v0 = a0 - u.lam * b0, v1 = a1 - u.lam * b1;
      float ss = v0 * v0 + v1 * v1;
      ss = ::wave_sum(ss);
      const float rn = 1.0f / sqrtf(ss * (1.0f / 128.0f) + 1e-6f);
      op[(long)r * (LDO / 2)] = pk2(v0 * rn * g0, v1 * rn * g1);
    }
  } else {
#pragma unroll 8
    for (int r = 0; r < 32; ++r) op[(long)r * (LDO / 2)] = pk2(s0[r * 128], s0[r * 128 + 1]);
  }
}
#undef SBAR
#undef KSWZ
}
struct Args { const float* in[22]; float* out; unsigned char* ws; int ph_lo, ph_hi; };
enum { I_X = 0, I_C, I_CTX, I_CCTX, I_GMIX, I_GMLP, I_WMOD, I_BMOD, I_WIN, I_WOUT, I_GQ, I_GK, I_RPB, I_LQ1, I_LK1, I_LQ2, I_LK2, I_GSUB, I_SINK, I_WUP, I_WDN, I_GFIN };
typedef float f32x4g __attribute__((ext_vector_type(4)));
typedef unsigned v4u __attribute__((ext_vector_type(4)));

__device__ __forceinline__ void transpose_item(const float* W, int K, int N, bf16* WT, int ldt, LAS float* scr, int item, int lane) {
    const int nblk = N / 32, kb = item / nblk, nb = item % nblk, k0 = 64 * kb, n0 = 32 * nb;
#pragma unroll 8
    for (int i = 0; i < 32; ++i) { const int kk = 2 * i + (lane >> 5); scr[kk * 33 + (lane & 31)] = W[(size_t)(k0 + kk) * N + n0 + (lane & 31)]; }
    asm volatile("s_waitcnt lgkmcnt(0)" ::: "memory");
    const int c = lane & 7;
#pragma unroll
    for (int j = 0; j < 4; ++j) { const int n = (lane >> 3) + 8 * j; const LAS float* s = scr + (8 * c) * 33 + n;
        v4u o; o.x = pk2(s[0 * 33], s[1 * 33]); o.y = pk2(s[2 * 33], s[3 * 33]); o.z = pk2(s[4 * 33], s[5 * 33]); o.w = pk2(s[6 * 33], s[7 * 33]);
        *(v4u*)(WT + (size_t)(n0 + n) * ldt + k0 + 8 * c) = o; }
    asm volatile("s_waitcnt lgkmcnt(0)" ::: "memory");
}

__device__ __forceinline__ void weight_transposes(const Args& a, unsigned char* lds_, int l, int wg, int nwg_) {
    int tid_ = threadIdx.x; asm volatile("" : "+v"(tid_)); const int lane = tid_ & 63, wave = tid_ >> 6; const int gw = wg * NWAVES + wave, NGW = nwg_ * NWAVES;
    LAS float* scr = (LAS float*)((LAS unsigned char*)lds_ + wave * 16384);
    constexpr int I_IN = (DM / 64) * (PW / 32), I_OUT = (DM / 64) * (DM / 32), I_UP = (DM / 64) * (HID / 32), I_DN = (HID / 64) * (DM / 32), I_L = I_IN + I_OUT + I_UP + I_DN;
    bf16* wt = (bf16*)(a.ws + WS_WT + (size_t)l * WL_B);
    for (int it = gw; it < I_L; it += NGW) {
        int r = it;
        if (r < I_IN) { transpose_item(a.in[I_WIN] + (size_t)l * DM * PW, DM, PW, wt, DM, scr, r, lane); continue; } r -= I_IN;
        if (r < I_OUT) { transpose_item(a.in[I_WOUT] + (size_t)l * DM * DM, DM, DM, (bf16*)((unsigned char*)wt + WIN_B), DM, scr, r, lane); continue; } r -= I_OUT;
        if (r < I_UP) { transpose_item(a.in[I_WUP] + (size_t)l * DM * HID, DM, HID, (bf16*)((unsigned char*)wt + WIN_B + WOUT_B), DM, scr, r, lane); continue; } r -= I_UP;
        transpose_item(a.in[I_WDN] + (size_t)l * HID * DM, HID, DM, (bf16*)((unsigned char*)wt + WIN_B + WOUT_B + WUP_B), HIDP, scr, r, lane);
    }
}

__device__ __forceinline__ void phase_prologue(const Args& a, unsigned char* lds_, int G, int vcu) {
    int tid_ = threadIdx.x; asm volatile("" : "+v"(tid_)); const int tid = tid_, lane = tid & 63, wave = tid >> 6;
    float* cond = (float*)lds_;
    float* part = (float*)(lds_ + 9 * 2048 * 4);
    __syncthreads();
    for (int i = tid; i < 9 * 2048; i += NTHREADS) { const int r = i >> 11, k = i & 2047; const float v = r < 8 ? a.in[I_C][r * 2048 + k] : a.in[I_CCTX][k]; cond[i] = v / (1.0f + expf(-v)); }
    __syncthreads();
    float* MOD = (float*)(a.ws + WS_MOD);
    for (int item = blockIdx.x; item < 768; item += G) {
        const int l = item / 384, n0 = (item % 384) * 32;
        const float* W = a.in[I_WMOD] + (size_t)l * 2048 * MODW + n0;
        const int kq = tid >> 3, c4 = tid & 7;
        float acc[9][4];
#pragma unroll
        for (int r = 0; r < 9; ++r)
#pragma unroll
            for (int j = 0; j < 4; ++j) acc[r][j] = 0.f;
#pragma unroll 2
        for (int i0 = 0; i0 < 32; i0 += 4) {
            f32x4g w[4];
#pragma unroll
            for (int i = 0; i < 4; ++i) w[i] = *(const f32x4g*)(W + (size_t)(kq * 32 + i0 + i) * MODW + c4 * 4);
#pragma unroll
            for (int r = 0; r < 9; ++r) { const f32x4g cv = *(const f32x4g*)(cond + r * 2048 + kq * 32 + i0);
#pragma unroll
                for (int i = 0; i < 4; ++i)
#pragma unroll
                    for (int j = 0; j < 4; ++j) acc[r][j] += cv[i] * w[i][j]; }
        }
#pragma unroll
        for (int r = 0; r < 9; ++r)
#pragma unroll
            for (int j = 0; j < 4; ++j) { float v = acc[r][j]; v = sum_xor<8>(v); v = sum_xor<16>(v); v = sum_xor<32>(v); if (lane < 8) part[(wave * 9 + r) * 32 + c4 * 4 + j] = v; }
        __syncthreads();
        if (tid < 288) { const int r = tid >> 5, n = tid & 31; float s = 0.f;
#pragma unroll
            for (int w = 0; w < 8; ++w) s += part[(w * 9 + r) * 32 + n];
            MOD[(size_t)(l * 9 + r) * MODW + n0 + n] = s + a.in[I_BMOD][l * MODW + n0 + n]; }
        __syncthreads();
    }
    weight_transposes(a, lds_, 0, vcu, G); weight_transposes(a, lds_, 1, vcu, G);
    float* cosH = (float*)(a.ws + WS_ROPE); float* sinH = cosH + 2048 * 64; float* cosD = sinH + 2048 * 64; float* sinD = cosD + 2048 * 32;
    for (int i = blockIdx.x * NTHREADS + tid; i < 2048 * 96; i += G * NTHREADS) {
        if (i < 2048 * 64) { const int t = i >> 6, p = i & 63; const float pos = (float)(p < 32 ? (t >> 6) : (t & 63)); const float f = powf(10000.0f, -(float)(p & 31) / 32.0f); const float ang = pos * f; cosH[i] = cosf(ang); sinH[i] = sinf(ang); }
        else { const int k = i - 2048 * 64, t = k >> 5, p = k & 31; const float pos = (float)(p < 16 ? (t >> 6) : (t & 63)); const float f = powf(10000.0f, -(float)(p & 15) / 16.0f); const float ang = pos * f; cosD[k] = cosf(ang); sinD[k] = sinf(ang); }
    }
}

__device__ __forceinline__ void phase_norm(const void* xa, bool xa_bf16, const void* xb, bool xb_bf16, int M, const float* g, const float* modl, int shift_slot, int scale_slot, bf16* out, const float* part, const float* pgate, bf16* wb, int G, int vcu) {
    int tid_ = threadIdx.x; asm volatile("" : "+v"(tid_)); const int lane = tid_ & 63, wave = tid_ >> 6; const int gw = vcu * NWAVES + wave, NGW = G * NWAVES;
    for (int m = gw; m < M; m += NGW) {
        const int b = m < MX ? (m >> 11) : 8; const bool isb = m < MX ? xa_bf16 : xb_bf16; const size_t ro = m < MX ? (size_t)m * DM : (size_t)(m - MX) * DM; const void* src = m < MX ? xa : xb;
        f32x4g v[8]; float s = 0.f;
        if (isb) { const unsigned long long* bp = (const unsigned long long*)((const bf16*)src + ro) + lane;
#pragma unroll
            for (int j = 0; j < 8; ++j) { const unsigned long long w = bp[64 * j]; v[j].x = bf2f((unsigned)w & 0xffffu); v[j].y = bf2f(((unsigned)w) >> 16); v[j].z = bf2f((unsigned)(w >> 32) & 0xffffu); v[j].w = bf2f((unsigned)(w >> 48)); } }
        else { const f32x4g* xp = (const f32x4g*)((const float*)src + ro) + lane;
#pragma unroll
            for (int j = 0; j < 8; ++j) v[j] = xp[64 * j]; }
        if (part != nullptr && m >= MX) { const f32x4g* pp = (const f32x4g*)(part + (size_t)(m - MX) * DM) + lane; const f32x4g* pg = (const f32x4g*)pgate + lane;
#pragma unroll
            for (int j = 0; j < 8; ++j) { const f32x4g q = (pp[64 * j] + pp[64 * j + (size_t)MC * DM / 4]) + (pp[64 * j + 2 * ((size_t)MC * DM / 4)] + pp[64 * j + 3 * ((size_t)MC * DM / 4)]); v[j] += pg[64 * j] * q; }
            if (wb != nullptr) { unsigned long long* wp = (unsigned long long*)(wb + (size_t)(m - MX) * DM) + lane;
#pragma unroll
                for (int j = 0; j < 8; ++j) wp[64 * j] = (unsigned long long)pk2(v[j].x, v[j].y) | ((unsigned long long)pk2(v[j].z, v[j].w) << 32); } }
#pragma unroll
        for (int j = 0; j < 8; ++j) s += (v[j].x * v[j].x + v[j].y * v[j].y) + (v[j].z * v[j].z + v[j].w * v[j].w);
        const float rstd = 1.0f / sqrtf(wave_sum(s) * (1.0f / DM) + NORM_EPS);
        const f32x4g* gp = (const f32x4g*)g + lane; const f32x4g* shp = (const f32x4g*)(modl + (size_t)b * MODW + shift_slot * DM) + lane; const f32x4g* scp = (const f32x4g*)(modl + (size_t)b * MODW + scale_slot * DM) + lane;
        unsigned long long* o8 = (unsigned long long*)(out + (size_t)m * DM) + lane;
#pragma unroll
        for (int j = 0; j < 8; ++j) { const f32x4g gg = gp[64 * j], sh = shp[64 * j], sc = scp[64 * j]; const f32x4g y = (v[j] * rstd) * gg * (sc + 1.0f) + sh;
            o8[64 * j] = (unsigned long long)pk2(y.x, y.y) | ((unsigned long long)pk2(y.z, y.w) << 32); }
    }
}
__device__ __forceinline__ void phase_final(const bf16* x, const float* g, float* out, int G, int vcu) {
    int tid_ = threadIdx.x; asm volatile("" : "+v"(tid_)); const int lane = tid_ & 63, wave = tid_ >> 6; const int gw = vcu * NWAVES + wave, NGW = G * NWAVES;
    for (int m = gw; m < MX; m += NGW) {
        const unsigned long long* bp = (const unsigned long long*)(x + (size_t)m * DM) + lane; f32x4g v[8]; float s = 0.f;
#pragma unroll
        for (int j = 0; j < 8; ++j) { const unsigned long long w = bp[64 * j]; v[j].x = bf2f((unsigned)w & 0xffffu); v[j].y = bf2f(((unsigned)w) >> 16); v[j].z = bf2f((unsigned)(w >> 32) & 0xffffu); v[j].w = bf2f((unsigned)(w >> 48));
            s += (v[j].x * v[j].x + v[j].y * v[j].y) + (v[j].z * v[j].z + v[j].w * v[j].w); }
        const float rstd = 1.0f / sqrtf(wave_sum(s) * (1.0f / DM) + NORM_EPS);
        const f32x4g* gp = (const f32x4g*)g + lane; f32x4g* op = (f32x4g*)(out + (size_t)m * DM) + lane;
#pragma unroll
        for (int j = 0; j < 8; ++j) op[64 * j] = (v[j] * rstd) * gp[64 * j];
    }
}

__device__ __forceinline__ void phase_qkprep(bf16* P, const float* gq, const float* gk, const float* rope, int G, int vcu) {
    int tid_ = threadIdx.x; asm volatile("" : "+v"(tid_)); const int lane = tid_ & 63, wave = tid_ >> 6; const int gw = vcu * NWAVES + wave, NGW = G * NWAVES;
    const float* cosH = rope; const float* sinH = cosH + 2048 * 64; const float* cosD = sinH + 2048 * 64; const float* sinD = cosD + 2048 * 32;
    const float gq0 = gq[2 * lane], gq1 = gq[2 * lane + 1], gk0 = gk[2 * lane], gk1 = gk[2 * lane + 1];
    for (int m = gw; m < MT; m += NGW) {
        const bool lat = m < MX; const int pos = m & 2047;
        unsigned* row = (unsigned*)(P + (size_t)m * PW) + lane;
        float cH = 1.f, sH = 0.f, cD = 1.f, sD = 0.f;
        if (lat) { cH = cosH[pos * 64 + lane]; sH = sinH[pos * 64 + lane]; cD = cosD[pos * 32 + (lane & 31)]; sD = sinD[pos * 32 + (lane & 31)]; }
#pragma unroll
        for (int blk = 0; blk < 6; ++blk) {
            const unsigned w = row[blk * 64]; float x0 = bf2f(w & 0xffffu), x1 = bf2f(w >> 16);
            const float ss = wave_sum(x0 * x0 + x1 * x1); const float rn = 1.0f / sqrtf(ss * (1.0f / 128.0f) + NORM_EPS);
            x0 = x0 * rn * (blk < 4 ? gq0 : gk0); x1 = x1 * rn * (blk < 4 ? gq1 : gk1);
            const float y0 = x0 * cH - x1 * sH, y1 = x0 * sH + x1 * cH;
            row[blk * 64] = pk2(y0, y1);
        }
        if (lat) {
#pragma unroll
            for (int blk = 0; blk < 8; ++blk) {
                const unsigned w = row[(2560 / 2) + blk * 64]; const float x0 = bf2f(w & 0xffffu), x1 = bf2f(w >> 16);
                row[(2560 / 2) + blk * 64] = pk2(x0 * cD - x1 * sD, x0 * sD + x1 * cD);
            }
#pragma unroll
            for (int blk = 0; blk < 6; ++blk) {
                const unsigned w = row[(4096 / 2) + blk * 64]; const float x0 = bf2f(w & 0xffffu), x1 = bf2f(w >> 16);
                row[(4096 / 2) + blk * 64] = pk2(x0 * cH - x1 * sH, x0 * sH + x1 * cH);
            }
        }
    }
}

#ifndef AM1
#define AM1 1
#define AM2 2
#endif
__device__ __forceinline__ void phase_attention(const Args& a, int layer, unsigned char* lds_, int G, int vcu) {
    bf16* P = (bf16*)(a.ws + WS_P); bf16* AO = (bf16*)(a.ws + WS_AO);
    const float LOG2E = 1.4426950408889634f;
    const float lam_init = 0.8f - 0.6f * expf(-0.3f * (float)layer);
    float lam;
    { int lane = threadIdx.x & 63; asm volatile("" : "+v"(lane)); const float* q1 = a.in[I_LQ1] + layer * 64, *k1 = a.in[I_LK1] + layer * 64, *q2 = a.in[I_LQ2] + layer * 64, *k2 = a.in[I_LK2] + layer * 64;
      const float s1 = wave_sum(q1[lane] * k1[lane]), s2 = wave_sum(q2[lane] * k2[lane]); lam = expf(s1) - expf(s2) + lam_init; lam = __builtin_bit_cast(float, __builtin_amdgcn_readfirstlane(__builtin_bit_cast(int, lam))); }
    const int nround = layer == 0 ? 7 : 5;
    for (int vu = vcu; vu < 256; vu += G) {
    for (int round = 0; round < nround; ++round) {
        att::AttnUnit u; int type, b, h, qb; bool isctx = false; u.sub = 0;
        if (round < 5) { b = vu >> 5; h = (vu >> 3) & 3; qb = vu & 7;
            const int rr = (h < 2) ? round : (round + 2) % 5;
            type = rr < 2 ? 2 : (rr == 2 ? 0 : (rr == 3 ? 1 : 3)); u.sub = rr == 1 ? 1 : 0; }
        else { if (vu & 1) continue; const int idx = vu >> 1; b = idx >> 4; type = (idx >> 2) & 3; h = idx & 3; qb = 0; isctx = true; if (round == 6) { if (type != 2) continue; u.sub = 1; } }
        const int kvh = (type == 0 || type == 3) ? (h >> 1) : h;
        const int qcol = type == 0 ? h * 128 : type == 1 ? 1024 + h * 128 : type == 2 ? 2560 + h * 128 : 4096 + h * 128;
        const int kcol = type == 0 ? 512 + kvh * 128 : type == 1 ? 1536 + kvh * 128 : type == 2 ? 3072 + kvh * 128 : 4608 + kvh * 128;
        const int vcol = type == 0 ? 768 + kvh * 128 : type == 1 ? 2048 + kvh * 128 : type == 2 ? 3584 + kvh * 128 : 4864 + kvh * 128;
        const int ocol = type * 512 + h * 128;
        const int qrow0 = isctx ? MX + b * CTXL : b * SEQ + qb * 256;
        u.Q = P + ((size_t)(qcol >> 7) * MT + qrow0) * 128; u.K = P + (size_t)(kcol >> 7) * MT * 128; u.V = P + (size_t)(vcol >> 7) * MT * 128; u.O = AO + (size_t)qrow0 * DM + ocol;
        u.ctx_row0 = MX + b * CTXL; u.nctx = 4; u.qpos0 = qb * 256;
        int t_lo = 0, nlat = 32;
        if (isctx) nlat = 0;
        else if (type == 1) { const int r0 = qb * 4; int lo = r0 - 4; lo = lo < 0 ? 0 : (lo > 24 ? 24 : lo); int hi = r0 - 1; hi = hi < 0 ? 0 : (hi > 24 ? 24 : hi); hi += 8; if ((hi - lo) & 1) hi += 1; t_lo = lo; nlat = hi - lo; }
        else if (type == 3) { int lo = qb * 4 - 2; lo = lo < 0 ? 0 : lo; int hi = qb * 4 + 6; hi = hi > 32 ? 32 : hi; t_lo = lo; nlat = hi - lo; }
        u.lat_row0 = b * SEQ + t_lo * 64; u.kpos0 = t_lo * 64; u.nt = 4 + nlat;
        const float scale = type == 2 ? 0.125f : 0.088388347648318440f;
        u.C = scale * LOG2E; u.thr_raw = 8.0f / scale;
        u.nsub = type == 2 ? 2 : 1; u.lam = lam; u.post = 1.0f - lam_init; u.gsub = a.in[I_GSUB] + layer * 128;
        u.has_sink = type == 3; u.sink = type == 3 ? a.in[I_SINK][layer * 4 + h] : 0.f;
        u.rpb = a.in[I_RPB] + (size_t)(layer * 4 + h) * 465;
        u.stash = (float*)(a.ws + WS_STASH) + (size_t)blockIdx.x * 2 * 256 * 128;
#ifdef ATT_DUP_ROUND
        for (int dup_ = 0; dup_ < (round == ATT_DUP_ROUND ? 2 : 1); ++dup_) {
#else
        {
#endif
        if (!isctx && type == 1) att::attn_unit<AM1, true>(u, (char*)lds_);
        else if (!isctx && type == 3) att::attn_unit<AM2, true>(u, (char*)lds_);
        else if (type == 2) att::attn_unit<0, false>(u, (char*)lds_);
        else att::attn_unit<0, true>(u, (char*)lds_);
        att::unit_finish(u);
        }
    }
    }
}
#ifndef PHMASK
#define PHMASK 1023
#endif
#ifndef REP_ATT
#define REP_ATT 1
#endif
#ifndef REP_UP
#define REP_UP 1
#endif
#ifndef REP_IN
#define REP_IN 1
#endif
#ifndef REP_PRO
#define REP_PRO 1
#endif
#ifndef REP_SYNC
#define REP_SYNC 1
#endif
#ifndef REP_NORM
#define REP_NORM 1
#endif
#ifndef REP_INQK
#define REP_INQK 1
#endif
#ifndef REP_DN
#define REP_DN 1
#endif
#ifndef DN_WGM
#define DN_WGM 4
#endif
#ifndef USE_XB
#define USE_XB 0
#endif
#ifndef RES_SP2
#define RES_SP2 true
#endif
#ifndef DN_KCH
#define DN_KCH 1
#endif
#ifndef MK_COOP
#define MK_COOP 1
#endif
constexpr int N_PHASES = 18;
__global__ void __launch_bounds__(NTHREADS) fwd_kernel(Args a) {
    extern __shared__ __attribute__((aligned(16))) unsigned char lds[];
    cg::grid_group grid = cg::this_grid();
    const int G = gridDim.x, bx = blockIdx.x;
    const int vcu = (G % 8 == 0) ? (bx % 8) * (G / 8) + bx / 8 : bx;
#define IN(k) (a.ph_lo <= (k) && (k) < a.ph_hi)
#define SEAM(k) do { if (IN(k) && IN((k) + 1)) for (int rs_ = 0; rs_ < REP_SYNC; ++rs_) { if (a.ph_lo < 0) grid.sync(); else xcd_barrier(xbar); }     } while (0)
    unsigned char* ws = a.ws;
    volatile LAS unsigned* xst = (volatile LAS unsigned*)((LAS unsigned char*)lds + 131072 + 64);
    if (threadIdx.x < 2) xst[threadIdx.x] = 0u;
    __syncthreads();
    XcdBarrier xbar; xbar.bar = (unsigned*)ws; xbar.x = 0; xbar.st = nullptr;
    if (a.ph_hi - a.ph_lo > 1) xbar = xcd_barrier_post((unsigned*)ws, xst);
    #if PHMASK & 1
    if (IN(0)) for (int rep_ = 0; rep_ < REP_PRO; ++rep_) phase_prologue(a, lds, G, vcu);
#endif
    SEAM(0);
    for (int l = 0; l < 2; ++l) {
        const int pb = 1 + 8 * l;
        asm volatile("" : "+s"(ws));
        bf16* X = (bf16*)(ws + WS_X); bf16* H0 = (bf16*)(ws + WS_H0); bf16* P = (bf16*)(ws + WS_P); bf16* AO = (bf16*)(ws + WS_AO); bf16* HM = (bf16*)(ws + WS_BIG);
        const float* modl = (const float*)(ws + WS_MOD) + (size_t)l * 9 * MODW;
        const bf16* Win = (const bf16*)(ws + WS_WT + (size_t)l * WL_B); const bf16* Wout = (const bf16*)((const unsigned char*)Win + WIN_B);
        const bf16* Wup = (const bf16*)((const unsigned char*)Wout + WOUT_B); const bf16* Wdn = (const bf16*)((const unsigned char*)Wup + WUP_B);
        const int M2 = l == 0 ? MT : MX;
#if PHMASK & 2
        if (IN(pb + 0)) for (int rep_ = 0; rep_ < REP_NORM; ++rep_) phase_norm(l == 0 ? (const void*)a.in[I_X] : (const void*)X, l == 1, l == 0 ? (const void*)a.in[I_CTX] : (const void*)(X + (size_t)MX * DM), l == 1, MT, a.in[I_GMIX] + l * DM, modl, 0, 1, H0, l == 1 ? (const float*)(ws + WS_STASH) : nullptr, (const float*)(ws + WS_MOD) + 8 * MODW + 5 * DM, nullptr, G, vcu);
#endif
        SEAM(pb + 0);
        for (int rq_ = 0; rq_ < REP_INQK; ++rq_) {
#if PHMASK & 4
        if (IN(pb + 1)) for (int rep_ = 0; rep_ < REP_IN; ++rep_) { pg8::Gemm g{H0, Win, MT, PW, DM, DM}; pg8::StaticOrder S; S.init(MT, PW, G, bx); pg8::EpiInProj E{P, MT, a.in[I_GQ] + l * 128, a.in[I_GK] + l * 128, (const float*)(ws + WS_ROPE), (LAS float*)((LAS unsigned char*)lds + 131072 + 1024)};
            pg8::gemm_phase<pg8::EpiInProj, pg8::StaticOrder, true, true>((LAS unsigned char*)lds, g, S, E); }
#endif
        SEAM(pb + 1);
        }
#if PHMASK & 16
        if (IN(pb + 3)) for (int rep_ = 0; rep_ < REP_ATT; ++rep_) phase_attention(a, l, lds, G, vcu);
#endif
        SEAM(pb + 3);
#if PHMASK & 32
        if (IN(pb + 4)) {
            { pg8::Gemm g{AO, Wout, MX, DM, DM, DM}; pg8::ChunkOrder S; S.init(MX, DM, G, bx, 8, 1);
              if (l == 0) { pg8::EpiResidB<true> E{a.in[I_X], nullptr, X, modl + 2 * DM}; pg8::gemm_phase<pg8::EpiResidB<true>, pg8::ChunkOrder, true, RES_SP2>((LAS unsigned char*)lds, g, S, E); }
              else { pg8::EpiResidB<false> E{nullptr, X, X, modl + 2 * DM}; pg8::gemm_phase<pg8::EpiResidB<false>, pg8::ChunkOrder, true, RES_SP2>((LAS unsigned char*)lds, g, S, E); } }
            if (l == 0) {
              pg8::Gemm g{AO, Wout, MT, DM, DM, DM / 4}; pg8::SplitOrder S; S.init(MX / 256, MC / 256, DM / 256, 4, G, bx); pg8::EpiPart E{(float*)(ws + WS_STASH), MX / 256, (size_t)MC * DM};
              pg8::gemm_phase<pg8::EpiPart, pg8::SplitOrder, true, true>((LAS unsigned char*)lds, g, S, E); }
        }
#endif
        SEAM(pb + 4);
#if PHMASK & 64
        if (IN(pb + 5)) for (int rep_ = 0; rep_ < REP_NORM; ++rep_) phase_norm(X, true, l == 0 ? (const void*)a.in[I_CTX] : (const void*)(X + (size_t)MX * DM), l == 1, M2, a.in[I_GMLP] + l * DM, modl, 3, 4, H0, l == 0 ? (const float*)(ws + WS_STASH) : nullptr, (const float*)(ws + WS_MOD) + 8 * MODW + 2 * DM, l == 0 ? X + (size_t)MX * DM : nullptr, G, vcu);
#endif
        SEAM(pb + 5);
#if PHMASK & 128
        if (IN(pb + 6)) for (int rep_ = 0; rep_ < REP_UP; ++rep_) { pg8::Gemm g{H0, Wup, M2, HID, DM, DM}; pg8::StaticOrder S; S.init(M2, HID, G, bx); pg8::EpiStore<1> E{HM, HIDP};
            pg8::gemm_phase<pg8::EpiStore<1>, pg8::StaticOrder, true, true>((LAS unsigned char*)lds, g, S, E); }
#endif
        SEAM(pb + 6);
#if PHMASK & 256
        if (IN(pb + 7)) {
            { const int nch = (((MX / 256) * (DM / 256)) % G == 0) ? DN_KCH : 1;
              pg8::Gemm g{HM, Wdn, MX, DM, HIDP, HID / nch}; pg8::ChunkOrder S; S.init(MX, DM, G, bx, DN_WGM, nch); pg8::EpiResidB<false> E{nullptr, X, X, modl + 5 * DM};
              pg8::gemm_phase<pg8::EpiResidB<false>, pg8::ChunkOrder, true, RES_SP2>((LAS unsigned char*)lds, g, S, E); }
            if (l == 0) {
              pg8::Gemm g{HM, Wdn, MT, DM, HIDP, HID / 4}; pg8::SplitOrder S; S.init(MX / 256, MC / 256, DM / 256, 4, G, bx); pg8::EpiPart E{(float*)(ws + WS_STASH), MX / 256, (size_t)MC * DM};
              pg8::gemm_phase<pg8::EpiPart, pg8::SplitOrder, true, true>((LAS unsigned char*)lds, g, S, E); }
        }
#endif
        SEAM(pb + 7);
    }
#if PHMASK & 512
    if (IN(17)) phase_final((const bf16*)(ws + WS_X), a.in[I_GFIN], a.out, G, vcu);
#endif
#undef IN
#undef SEAM
}

extern "C" void kernel_launch(void* const* d_in, const int* in_sizes, int n_in, void* d_out, int out_size, void* d_ws, size_t ws_size, hipStream_t stream) {
    static int grid = 0;
    if (grid == 0) {
        if (n_in != 22 || out_size != MX * DM || ws_size < WS_END) { fprintf(stderr, "kernel_launch: unexpected shapes (n_in %d out %d ws %zu need %zu)\n", n_in, out_size, ws_size, (size_t)WS_END); grid = -1; return; }
        int dev = 0, cus = 0, per_cu = 0;
        hipGetDevice(&dev); hipDeviceGetAttribute(&cus, hipDeviceAttributeMultiprocessorCount, dev);
        if (hipFuncSetAttribute((const void*)fwd_kernel, hipFuncAttributeMaxDynamicSharedMemorySize, LDS_BYTES) != hipSuccess) { fprintf(stderr, "kernel_launch: hipFuncSetAttribute failed\n"); grid = -1; return; }
        if (hipOccupancyMaxActiveBlocksPerMultiprocessor(&per_cu, (const void*)fwd_kernel, NTHREADS, LDS_BYTES) != hipSuccess || per_cu < 1) { fprintf(stderr, "kernel_launch: occupancy query gave %d\n", per_cu); per_cu = 1; }
        (void)hipGetLastError();
        grid = cus * per_cu;
        fprintf(stderr, "kernel_launch: grid %d (cus %d x %d)\n", grid, cus, per_cu);
    }
    if (grid < 0) return;
    (void)hipMemsetAsync(d_ws, 0, 16384, stream);
    Args a{};
    for (int i = 0; i < 22; ++i) a.in[i] = (const float*)d_in[i];
    a.out = (float*)d_out; a.ws = (unsigned char*)d_ws;
#if MK_COOP
    a.ph_lo = 0; a.ph_hi = N_PHASES;
    void* args[] = {&a};
    hipError_t e = hipLaunchCooperativeKernel((const void*)fwd_kernel, dim3(grid), dim3(NTHREADS), args, LDS_BYTES, stream);
    if (e != hipSuccess) fprintf(stderr, "kernel_launch: cooperative launch failed: %s (grid %d)\n", hipGetErrorString(e), grid);
#else
    for (int ph = 0; ph < N_PHASES; ++ph) { a.ph_lo = ph; a.ph_hi = ph + 1; hipLaunchKernelGGL(fwd_kernel, dim3(grid), dim3(NTHREADS), LDS_BYTES, stream, a); }
#endif
}
```

```cpp
#include <hip/hip_runtime.h>
#include <hip/hip_cooperative_groups.h>
#include <cstdio>
#include <cstdint>
namespace cg = cooperative_groups;

constexpr int DM = 2048, NB = 8, SEQ = 2048, CTXL = 256, PW = 5120, HID = 8192, HIDP = HID + 64  , NMOD = 6, MODW = NMOD * DM;
constexpr int MX = NB * SEQ, MC = NB * CTXL, MT = MX + MC;
constexpr float NORM_EPS = 1e-6f;
constexpr int NWAVES = 8, NTHREADS = 512;
constexpr int LDS_BYTES = 147456;
constexpr size_t WIN_B = (size_t)PW * DM * 2, WOUT_B = (size_t)DM * DM * 2, WUP_B = (size_t)HID * DM * 2, WDN_B = (size_t)DM * HIDP * 2, WL_B = WIN_B + WOUT_B + WUP_B + WDN_B;
constexpr size_t WS_WT = 1u << 20;
constexpr size_t WS_MOD = WS_WT + 2 * WL_B;
constexpr size_t MOD_B = (size_t)2 * 9 * MODW * 4;
constexpr size_t WS_ROPE = WS_MOD + MOD_B;
constexpr size_t ROPE_B = (size_t)2048 * 64 * 4 * 2 + (size_t)2048 * 32 * 4 * 2;
constexpr size_t WS_X = WS_ROPE + ROPE_B;
constexpr size_t X_B = (size_t)MT * DM * 4;
constexpr size_t WS_H0 = WS_X + X_B;
constexpr size_t H0_B = (size_t)MT * DM * 2;
constexpr size_t WS_BIG = WS_H0 + H0_B;
constexpr size_t BIG_B = (size_t)MT * HIDP * 2;
constexpr size_t WS_P = WS_BIG, P_B = (size_t)MT * PW * 2;
constexpr size_t WS_AO = WS_P + P_B, AO_B = (size_t)MT * DM * 2;
static_assert(WS_AO + AO_B <= WS_BIG + BIG_B, "overlay");
constexpr size_t WS_STASH = WS_BIG + BIG_B, STASH_B = (size_t)256 * 2 * 256 * 128 * 4;
constexpr size_t WS_END = WS_STASH + STASH_B;
static_assert(WS_MOD % 256 == 0 && WS_ROPE % 256 == 0 && WS_X % 256 == 0 && WS_H0 % 256 == 0 && WS_BIG % 256 == 0 && WS_AO % 256 == 0 && WS_STASH % 256 == 0, "align");

typedef unsigned short bf16;
#define LAS __attribute__((address_space(3)))
__device__ __forceinline__ float bf2f(unsigned v) { return __builtin_bit_cast(float, v << 16); }
__device__ __forceinline__ unsigned f2bf(float f) { unsigned u = __builtin_bit_cast(unsigned, f); return (u + 0x7fffu + ((u >> 16) & 1u)) >> 16; }
__device__ __forceinline__ unsigned pk2(float lo, float hi) { return f2bf(lo) | (f2bf(hi) << 16); }
template <int K> __device__ __forceinline__ float sum_xor(float v) {
    if constexpr (K < 32) return v + __builtin_bit_cast(float, __builtin_amdgcn_ds_swizzle(__builtin_bit_cast(int, v), (K << 10) | 0x1f));
    else { const unsigned b = __builtin_bit_cast(unsigned, v); auto rr = __builtin_amdgcn_permlane32_swap(b, b, false, false); return __builtin_bit_cast(float, (unsigned)rr[0]) + __builtin_bit_cast(float, (unsigned)rr[1]); }
}
__device__ __forceinline__ float wave_sum(float v) {
    v = sum_xor<1>(v); v = sum_xor<2>(v); v = sum_xor<4>(v); v = sum_xor<8>(v); v = sum_xor<16>(v); v = sum_xor<32>(v);
    return v;
}
#define MK_COOP 1
#define EPB_NBF 2
#define EPB_NBH 4
#define XB_TMO      128
#define XB_XCNT(j)  (256  + 64 * (j))
#define XB_XSUB(j)  (1280 + 64 * (j))
#define XB_XGEN(j)  (2304 + 64 * (j))
#define XB_TOP      3328
#define XB_TOPGEN   3392
#define XCD_BAR_WORDS 3456
#define XB_SPIN_CAP (1u << 18)

__device__ __forceinline__ unsigned xb_ld(unsigned* p)              { return __hip_atomic_load(p, __ATOMIC_RELAXED, __HIP_MEMORY_SCOPE_AGENT); }
__device__ __forceinline__ unsigned xb_add(unsigned* p, unsigned v) { return __hip_atomic_fetch_add(p, v, __ATOMIC_RELAXED, __HIP_MEMORY_SCOPE_AGENT); }
__device__ __forceinline__ unsigned xb_xcc_id() { return (unsigned)__builtin_amdgcn_s_getreg((3 << 11) | 20) & 0xFu; }
#define XB_SPIN(cond, bar) do { unsigned _sp = 0; while (cond) { __builtin_amdgcn_s_sleep(1); \
    if ((++_sp & 255u) == 0u) { if (xb_ld(&(bar)[XB_TMO])) break; if (_sp > XB_SPIN_CAP) { atomicAdd(&(bar)[XB_TMO], 1u); break; } } } } while (0)

struct XcdBarrier {
    unsigned* bar; unsigned x;
    volatile LAS unsigned* st;
};

__device__ __forceinline__ XcdBarrier xcd_barrier_post(unsigned* bar, volatile LAS unsigned* st) {
    XcdBarrier b; b.bar = bar; b.x = xb_xcc_id(); b.st = st;
    if (threadIdx.x == 0) (void)xb_add(&bar[XB_XCNT(b.x)], 1u);
    return b;
}
__device__ __forceinline__ void xcd_barrier_complete(unsigned* bar, unsigned x, unsigned& nloc, unsigned& nx) {
    const unsigned G = gridDim.x * gridDim.y * gridDim.z;
    unsigned sum, cnt, mine, sp = 0u;
    for (;;) {
        sum = 0u; cnt = 0u; mine = 0u;
#pragma unroll
        for (unsigned j = 0; j < 16; ++j) { const unsigned c = xb_ld(&bar[XB_XCNT(j)]); sum += c; cnt += (c > 0u) ? 1u : 0u; mine = (j == x) ? c : mine; }
        if (sum == G) break;
        __builtin_amdgcn_s_sleep(1);
        if ((++sp & 255u) == 0u) { if (xb_ld(&bar[XB_TMO])) break; if (sp > XB_SPIN_CAP) { atomicAdd(&bar[XB_TMO], 1u); break; } }
    }
    nloc = mine > 0u ? mine : 1u; nx = cnt > 0u ? cnt : 1u;
}

__device__ __forceinline__ void xcd_barrier(const XcdBarrier& b) {
    asm volatile("s_waitcnt vmcnt(0)" ::: "memory");
    __syncthreads();
    if (threadIdx.x == 0) {
        unsigned* bar = b.bar;
        __builtin_amdgcn_s_waitcnt(0);
        unsigned nloc = b.st[0], nx = b.st[1];
        if (nloc == 0u) { xcd_barrier_complete(bar, b.x, nloc, nx); b.st[0] = nloc; b.st[1] = nx; }
        const unsigned old = xb_add(&bar[XB_XSUB(b.x)], 1u);
        const unsigned gen = old / nloc;
        if (old + 1u == (gen + 1u) * nloc) {
            __builtin_amdgcn_fence(__ATOMIC_RELEASE, "agent");
            asm volatile("s_waitcnt vmcnt(0)" ::: "memory");
            const unsigned og = xb_add(&bar[XB_TOP], 1u);
            const unsigned tg = og / nx;
            if (og + 1u == (tg + 1u) * nx) xb_add(&bar[XB_TOPGEN], 1u);
            else XB_SPIN(xb_ld(&bar[XB_TOPGEN]) == tg, bar);
            __builtin_amdgcn_fence(__ATOMIC_ACQUIRE, "agent");
            xb_add(&bar[XB_XGEN(b.x)], 1u);
            asm volatile("s_waitcnt vmcnt(0)" ::: "memory");
        } else {
            XB_SPIN(xb_ld(&bar[XB_XGEN(b.x)]) == gen, bar);
            __builtin_amdgcn_fence(__ATOMIC_ACQUIRE, "agent");
            asm volatile("s_waitcnt vmcnt(0)" ::: "memory");
        }
    }
    __syncthreads();
}
namespace pg8 {
#define PG8_LAS __attribute__((address_space(3)))
typedef unsigned short bf16_t;
typedef short bf16x8 __attribute__((ext_vector_type(8)));
typedef float f32x4 __attribute__((ext_vector_type(4)));
typedef unsigned u32x4 __attribute__((ext_vector_type(4)));
constexpr int BM = 256, BK = 64, HALF = 128, HTB = HALF * BK * 2  , STAGE_BYTES = 8 * HTB, NXCD = 8, WGM = 8;

__host__ __device__ __forceinline__ int lds_byte(int r, int c) { const int st = (r >> 4) * 2 + (c >> 5), rr = r & 15, cc = c & 31, ob = rr * 64 + cc * 2; return st * 1024 + (ob ^ (((ob >> 9) & 1) << 5)); }
__host__ __device__ __forceinline__ void stage_rc(int b, int& R, int& C) { const int st = b / 1024, sb = b % 1024, swz = sb ^ (((sb >> 9) & 1) << 5); R = (st >> 1) * 16 + swz / 64; C = (st & 1) * 32 + (swz % 64) / 2; }
__host__ __device__ __forceinline__ int perm32(int rho) { const int n = rho >> 4, i = rho & 15; return 8 * (i >> 2) + 4 * n + (i & 3); }

struct Unit { int pm, pn, ks; };
struct Gemm { const bf16_t* A; const bf16_t* Bt; int M, N, K, Kext; };

struct StaticOrder {
    int nM, nN, nwg, G, c, wgm;
    __host__ __device__ void init(int M, int N, int G_, int c_, int wgm_ = WGM) { nM = M / BM; nN = N / BM; nwg = nM * nN; G = G_; c = c_; wgm = wgm_; }
    __host__ __device__ bool next(int i, Unit& u) const {
        const long L = (long)i * G + c; if (L >= nwg) return false;
        int wgid = (int)L; { const int q = nwg / NXCD, r = nwg % NXCD, xcd = wgid % NXCD, off = wgid / NXCD; wgid = (xcd < r ? xcd * (q + 1) : r * (q + 1) + (xcd - r) * q) + off; }
        const int nig = wgm * nN, gid = wgid / nig, fm = gid * wgm, gsz = (nM - fm) < wgm ? (nM - fm) : wgm;
        u.pm = fm + ((wgid % nig) % gsz); u.pn = (wgid % nig) / gsz; u.ks = 0; return true;
    }
    __device__ __forceinline__ void a_ready(const Unit&) const {}
    __device__ __forceinline__ void done(const Unit&) const {}
};

__device__ __forceinline__ unsigned cvt_pk_bf16(float lo, float hi) { unsigned r; asm volatile("v_cvt_pk_bf16_f32 %0, %1, %2" : "=v"(r) : "v"(lo), "v"(hi)); return r; }
typedef float f32x2 __attribute__((ext_vector_type(2)));
#ifdef EPI_NT
#define EPI_ST(T, p, v) __builtin_nontemporal_store((v), (T*)(p))
#else
#define EPI_ST(T, p, v) (*(T*)(p) = (v))
#endif
template <int ACT> struct EpiStore {
    static constexpr bool PERM = true, AFTER_DRAIN = false;
    bf16_t* O; int ldc;
    __device__ __forceinline__ void operator()(const f32x4 (&acc)[2][2][4][2], const Unit& u, int wr, int wc, int fr, int fq) const {
        const int row0 = u.pm * BM + wr * 64 + fr; const int col0 = u.pn * BM + wc * 32 + 8 * fq;
#pragma unroll
        for (int ai = 0; ai < 2; ++ai)
#pragma unroll
            for (int m = 0; m < 4; ++m) { bf16_t* rowp = O + (size_t)(row0 + ai * HALF + m * 16) * ldc + col0;
#pragma unroll
                for (int bj = 0; bj < 2; ++bj) { f32x4 v0 = acc[ai][bj][m][0], v1 = acc[ai][bj][m][1];
                    if (ACT == 1) {
#pragma unroll
                        for (int e = 0; e < 4; ++e) { float a = fmaxf(v0[e], 0.f), b = fmaxf(v1[e], 0.f); v0[e] = a * a; v1[e] = b * b; } }
                    u32x4 w; w.x = cvt_pk_bf16(v0[0], v0[1]); w.y = cvt_pk_bf16(v0[2], v0[3]); w.z = cvt_pk_bf16(v1[0], v1[1]); w.w = cvt_pk_bf16(v1[2], v1[3]);
                    EPI_ST(u32x4, rowp + bj * HALF, w); } }
    }
};
struct EpiResid {
    static constexpr bool PERM = false, AFTER_DRAIN = false;
    const float* resX; const float* resC; float* out; const float* gate; bf16_t* xb;
    __device__ __forceinline__ void operator()(const f32x4 (&acc)[2][2][4][2], const Unit& u, int wr, int wc, int fr, int fq) const {
        const int batch = u.pm < 64 ? (u.pm >> 3) : 8;
        const float* res = u.pm < 64 ? resX + (size_t)u.pm * BM * 2048 : resC + (size_t)(u.pm - 64) * BM * 2048;
        float* o = out + (size_t)u.pm * BM * 2048;
        const int col0 = u.pn * BM + wc * 32 + 4 * fq;
        const float* gp = gate + (size_t)batch * 12288 + col0;
        f32x4 gv[2][2];
#pragma unroll
        for (int bj = 0; bj < 2; ++bj)
#pragma unroll
            for (int n = 0; n < 2; ++n) gv[bj][n] = *(const f32x4*)(gp + bj * HALF + n * 16);
#pragma unroll
        for (int ai = 0; ai < 2; ++ai)
#pragma unroll
          for (int mh = 0; mh < 2; ++mh) {
            f32x4 rv[2][2][2];
#pragma unroll
            for (int mm = 0; mm < 2; ++mm) { const int m = mh * 2 + mm; const size_t off = (size_t)(ai * HALF + wr * 64 + m * 16 + fr) * 2048 + col0;
#pragma unroll
                for (int bj = 0; bj < 2; ++bj)
#pragma unroll
                    for (int n = 0; n < 2; ++n) rv[mm][bj][n] = *(const f32x4*)(res + off + bj * HALF + n * 16); }
            __builtin_amdgcn_sched_barrier(0);
#pragma unroll
            for (int mm = 0; mm < 2; ++mm) { const int m = mh * 2 + mm; const size_t off = (size_t)(ai * HALF + wr * 64 + m * 16 + fr) * 2048 + col0;
#pragma unroll
                for (int bj = 0; bj < 2; ++bj)
#pragma unroll
                    for (int n = 0; n < 2; ++n) { const f32x4 y = rv[mm][bj][n] + gv[bj][n] * acc[ai][bj][m][n]; EPI_ST(f32x4, o + off + bj * HALF + n * 16, y);
                        if (xb) { typedef unsigned u32x2 __attribute__((ext_vector_type(2))); u32x2 w; w.x = cvt_pk_bf16(y[0], y[1]); w.y = cvt_pk_bf16(y[2], y[3]); *(u32x2*)(xb + (size_t)u.pm * BM * 2048 + off + bj * HALF + n * 16) = w; } } }
            __builtin_amdgcn_sched_barrier(0);
          }
    }
};

struct EpiPart {
    static constexpr bool PERM = false, AFTER_DRAIN = false;
    float* part; int pm0; size_t slice;
    __device__ __forceinline__ void operator()(const f32x4 (&acc)[2][2][4][2], const Unit& u, int wr, int wc, int fr, int fq) const {
        float* o = part + (size_t)u.ks * slice + (size_t)(u.pm - pm0) * BM * 2048;
        const int col0 = u.pn * BM + wc * 32 + 4 * fq;
#pragma unroll
        for (int ai = 0; ai < 2; ++ai)
#pragma unroll
            for (int m = 0; m < 4; ++m) { const size_t off = (size_t)(ai * HALF + wr * 64 + m * 16 + fr) * 2048 + col0;
#pragma unroll
                for (int bj = 0; bj < 2; ++bj)
#pragma unroll
                    for (int n = 0; n < 2; ++n) EPI_ST(f32x4, o + off + bj * HALF + n * 16, acc[ai][bj][m][n]); }
    }
};
struct SplitOrder {
    int pm0, nM, nN, NS, G, c;
    __host__ __device__ void init(int pm0_, int nM_, int nN_, int NS_, int G_, int c_) { pm0 = pm0_; nM = nM_; nN = nN_; NS = NS_; G = G_; c = c_; }
    __host__ __device__ bool next(int i, Unit& u) const {
        const long L = (long)i * G + c; if (L >= (long)nM * nN * NS) return false;
        const int t = (int)L / NS; u.ks = (int)L % NS; u.pm = pm0 + t % nM; u.pn = t / nM; return true;
    }
    __device__ __forceinline__ void a_ready(const Unit&) const {}
    __device__ __forceinline__ void done(const Unit&) const {}
};

struct EpiInProj {
    static constexpr bool PERM = true, AFTER_DRAIN = false;
    bf16_t* O; int ldc; const float* gq; const float* gk; const float* rope; PG8_LAS float* red;
    __device__ __forceinline__ void operator()(const f32x4 (&acc)[2][2][4][2], const Unit& u, int wr, int wc, int fr, int fq) const {
        const int pn = u.pn; const bool lat = u.pm < 64;
        const int kind = pn <= 2 ? 1 : ((pn >= 10 && pn <= 13) ? 2 : ((pn >= 16 && pn <= 18) ? 3 : 0));
        const int row0 = u.pm * BM + wr * 64 + fr; const int col0 = pn * BM + wc * 32 + 8 * fq;
        const bool do_rope = lat && kind != 0;
        f32x4 g0 = (f32x4){1.f, 1.f, 1.f, 1.f}, g1 = g0;
        if (kind == 1) {
            const float* gp = (pn < 2 ? gq : gk) + wc * 32 + 8 * fq; g0 = *(const f32x4*)gp; g1 = *(const f32x4*)(gp + 4);
#pragma unroll
            for (int ai = 0; ai < 2; ++ai)
#pragma unroll
                for (int m = 0; m < 4; ++m)
#pragma unroll
                    for (int bj = 0; bj < 2; ++bj) { const f32x4 a = acc[ai][bj][m][0], b = acc[ai][bj][m][1];
                        float s = (a[0] * a[0] + a[1] * a[1]) + (a[2] * a[2] + a[3] * a[3]) + (b[0] * b[0] + b[1] * b[1]) + (b[2] * b[2] + b[3] * b[3]);
                        s = ::sum_xor<16>(s); s = ::sum_xor<32>(s);
                        if (fq == 0) red[((ai * HALF + wr * 64 + m * 16 + fr) * 2 + bj) * 4 + wc] = s; }
            asm volatile("s_waitcnt lgkmcnt(0)" ::: "memory"); __builtin_amdgcn_s_barrier(); asm volatile("" ::: "memory");
        }
        const float* cosT = rope; const float* sinT = rope + 2048 * 64; int tw = 64, p0 = wc * 16 + 4 * fq;
        if (kind == 2) { cosT = rope + 2 * 2048 * 64; sinT = cosT + 2048 * 32; tw = 32; p0 = (wc & 1) * 16 + 4 * fq; }
        f32x4 csa[2][4], sna[2][4];
#pragma unroll
        for (int ai = 0; ai < 2; ++ai)
#pragma unroll
            for (int m = 0; m < 4; ++m) { csa[ai][m] = (f32x4){1.f, 1.f, 1.f, 1.f}; sna[ai][m] = (f32x4){0.f, 0.f, 0.f, 0.f};
                if (do_rope) { const int pos = (row0 + ai * HALF + m * 16) & 2047; csa[ai][m] = *(const f32x4*)(cosT + pos * tw + p0); sna[ai][m] = *(const f32x4*)(sinT + pos * tw + p0); } }
        __builtin_amdgcn_sched_barrier(0);
#pragma unroll
        for (int ai = 0; ai < 2; ++ai)
#pragma unroll
            for (int m = 0; m < 4; ++m) { const int row = row0 + ai * HALF + m * 16; bf16_t* rowp = O + ((size_t)(pn * 2) * ldc + row) * 128 + wc * 32 + 8 * fq;
                const f32x4 cs = csa[ai][m], sn = sna[ai][m];
#pragma unroll
                for (int bj = 0; bj < 2; ++bj) { f32x4 v0 = acc[ai][bj][m][0], v1 = acc[ai][bj][m][1];
                    if (kind == 1) { const f32x4 t = *(const PG8_LAS f32x4*)(red + ((ai * HALF + wr * 64 + m * 16 + fr) * 2 + bj) * 4);
                        const float r = 1.0f / sqrtf(((t[0] + t[1]) + (t[2] + t[3])) * (1.0f / 128.0f) + 1e-6f); v0 = v0 * r * g0; v1 = v1 * r * g1; }
                    if (kind != 0) { const f32x4 a = v0, b = v1;
                        v0[0] = a[0] * cs[0] - a[1] * sn[0]; v0[1] = a[0] * sn[0] + a[1] * cs[0]; v0[2] = a[2] * cs[1] - a[3] * sn[1]; v0[3] = a[2] * sn[1] + a[3] * cs[1];
                        v1[0] = b[0] * cs[2] - b[1] * sn[2]; v1[1] = b[0] * sn[2] + b[1] * cs[2]; v1[2] = b[2] * cs[3] - b[3] * sn[3]; v1[3] = b[2] * sn[3] + b[3] * cs[3]; }
                    u32x4 w; w.x = cvt_pk_bf16(v0[0], v0[1]); w.y = cvt_pk_bf16(v0[2], v0[3]); w.z = cvt_pk_bf16(v1[0], v1[1]); w.w = cvt_pk_bf16(v1[2], v1[3]);
                    EPI_ST(u32x4, rowp + (size_t)bj * ldc * 128, w); } }
    }
};

struct ChunkOrder {
    StaticOrder S; int nr, nch;
    __host__ __device__ void init(int M, int N, int G_, int c_, int wgm_, int nch_) { S.init(M, N, G_, c_, wgm_); nr = (S.nwg + G_ - 1) / G_; nch = nch_; }
    __host__ __device__ bool next(int i, Unit& u) const { const int ch = i / nr; if (ch >= nch) return false; const bool ok = S.next(i - ch * nr, u); u.ks = ch; return ok; }
    __device__ __forceinline__ void a_ready(const Unit&) const {}
    __device__ __forceinline__ void done(const Unit&) const {}
};

#ifndef EPB_NBF
#define EPB_NBF 1
#endif
#ifndef EPB_NBH
#define EPB_NBH 2
#endif
template <bool RES_F32> struct EpiResidB {
    static constexpr bool PERM = true, AFTER_DRAIN = false;
    const float* resf; const bf16_t* resh; bf16_t* out; const float* gate;
    __device__ __forceinline__ void operator()(const f32x4 (&acc)[2][2][4][2], const Unit& u, int wr, int wc, int fr, int fq) const {
        const int batch = u.pm >> 3;
        int rl = wr * 64 + fr; asm volatile("" : "+v"(rl));
        const size_t rbase = (size_t)u.pm * BM * 2048;
        bf16_t* o = out + (size_t)u.pm * BM * 2048;
        const int col0 = u.pn * BM + wc * 32 + 8 * fq;
        const float* gp = gate + (size_t)batch * 12288 + col0;
        f32x4 gv[2][2];
#pragma unroll
        for (int bj = 0; bj < 2; ++bj)
#pragma unroll
            for (int n = 0; n < 2; ++n) gv[bj][n] = *(const f32x4*)(gp + bj * HALF + 4 * n);
        constexpr int NB = RES_F32 ? EPB_NBF : EPB_NBH;
#pragma unroll
        for (int ai = 0; ai < 2; ++ai)
#pragma unroll
          for (int mbi = 0; mbi < 4 / NB; ++mbi) { const int mb = mbi * NB;
            f32x4 rf[NB][2][2]; u32x4 rw[NB][2];
#pragma unroll
            for (int mm = 0; mm < NB; ++mm) { const int m = mb + mm; const size_t off = (size_t)(ai * HALF + m * 16 + rl) * 2048 + col0;
#pragma unroll
                for (int bj = 0; bj < 2; ++bj) {
                    if constexpr (RES_F32) { const float* rp = resf + rbase + off + bj * HALF; rf[mm][bj][0] = *(const f32x4*)rp; rf[mm][bj][1] = *(const f32x4*)(rp + 4); }
                    else rw[mm][bj] = *(const u32x4*)(resh + rbase + off + bj * HALF); } }
            __builtin_amdgcn_sched_barrier(0);
#pragma unroll
            for (int mm = 0; mm < NB; ++mm) { const int m = mb + mm; const size_t off = (size_t)(ai * HALF + m * 16 + rl) * 2048 + col0;
#pragma unroll
                for (int bj = 0; bj < 2; ++bj) { f32x4 r0, r1;
                    if constexpr (RES_F32) { r0 = rf[mm][bj][0]; r1 = rf[mm][bj][1]; }
                    else { const u32x4 w = rw[mm][bj];
                        r0 = (f32x4){__builtin_bit_cast(float, w.x << 16), __builtin_bit_cast(float, w.x & 0xffff0000u), __builtin_bit_cast(float, w.y << 16), __builtin_bit_cast(float, w.y & 0xffff0000u)};
                        r1 = (f32x4){__builtin_bit_cast(float, w.z << 16), __builtin_bit_cast(float, w.z & 0xffff0000u), __builtin_bit_cast(float, w.w << 16), __builtin_bit_cast(float, w.w & 0xffff0000u)}; }
                    const f32x4 y0 = r0 + gv[bj][0] * acc[ai][bj][m][0], y1 = r1 + gv[bj][1] * acc[ai][bj][m][1];
                    u32x4 w2; w2.x = cvt_pk_bf16(y0[0], y0[1]); w2.y = cvt_pk_bf16(y0[2], y0[3]); w2.z = cvt_pk_bf16(y1[0], y1[1]); w2.w = cvt_pk_bf16(y1[2], y1[3]);
                    EPI_ST(u32x4, o + off + bj * HALF, w2); } }
            __builtin_amdgcn_sched_barrier(0);
          }
    }
};
template <class Epi, class Sched, bool ALIGN_EPI = false, bool SP2 = false>
__device__ __forceinline__ void gemm_phase(PG8_LAS unsigned char* lds, const Gemm g, const Sched& S, const Epi& E) {
    int tid_ = threadIdx.x; asm volatile("" : "+v"(tid_));
    const int tid = tid_, wid = __builtin_amdgcn_readfirstlane(tid >> 6), lane = tid & 63, wr = wid >> 2, wc = wid & 3, fr = lane & 15, fq = lane >> 4;
    const int K = g.K, nt = g.Kext / BK; const size_t sstep = (size_t)g.Kext * 2;
    unsigned voffA[2], voffB[2];
#pragma unroll
    for (int i = 0; i < 2; ++i) { int R, C; stage_rc(tid * 16 + i * 8192, R, C); const int Rb = Epi::PERM ? ((R & ~31) + perm32(R & 31)) : R;
        voffA[i] = (unsigned)(R * K + C) * 2u; voffB[i] = (unsigned)(Rb * K + C) * 2u; }
    const size_t kstep = (size_t)(BK * 2);
    const size_t hstep = (size_t)HALF * K * 2;
    const size_t tstep = 2 * hstep;
    const unsigned ldsw = (unsigned)wid * 1024u;
    const int aoff = lds_byte(wr * 64 + fr, fq * 8), boff = lds_byte(wc * 32 + fr, fq * 8);
#define PG8_SA(b, h) (((b) * 2 + (h)) * HTB)
#define PG8_SB(b, h) ((4 + (b) * 2 + (h)) * HTB)
#define PG8_STAGE(bufoff, gbase, voff) do { _Pragma("unroll") for (int _i = 0; _i < 2; ++_i) \
        __builtin_amdgcn_global_load_lds((const unsigned*)((const char*)(gbase) + (voff)[_i]), (PG8_LAS unsigned*)(lds + (bufoff) + ldsw + _i * 8192), 16, 0, 0); } while (0)
#define PG8_LDA(dst, b, h) do { _Pragma("unroll") for (int m = 0; m < 4; ++m) _Pragma("unroll") for (int k = 0; k < 2; ++k) dst[m][k] = *(const PG8_LAS bf16x8*)(lds + PG8_SA(b, h) + aoff + m * 2048 + k * 1024); } while (0)
#define PG8_LDB(dst, b, h) do { _Pragma("unroll") for (int n = 0; n < 2; ++n) _Pragma("unroll") for (int k = 0; k < 2; ++k) dst[n][k] = *(const PG8_LAS bf16x8*)(lds + PG8_SB(b, h) + boff + n * 2048 + k * 1024); } while (0)
#define PG8_MMA(ai, bj, At, Bt) do { __builtin_amdgcn_s_setprio(1); _Pragma("unroll") for (int m = 0; m < 4; ++m) _Pragma("unroll") for (int n = 0; n < 2; ++n) _Pragma("unroll") for (int k = 0; k < 2; ++k) \
        acc[ai][bj][m][n] = __builtin_amdgcn_mfma_f32_16x16x32_bf16(Bt[n][k], At[m][k], acc[ai][bj][m][n], 0, 0, 0); __builtin_amdgcn_s_setprio(0); } while (0)
#define PG8_WAIT_V(n) asm volatile("s_waitcnt vmcnt(" #n ")" ::: "memory")
#define PG8_WAIT_L(n) asm volatile("s_waitcnt lgkmcnt(" #n ")" ::: "memory")
#define PG8_BAR __builtin_amdgcn_s_barrier()
#define PG8_SCHED __builtin_amdgcn_sched_barrier(0)
    Unit cur, nxt; int ui = 0;
    if (!S.next(0, cur)) return;
    f32x4 acc[2][2][4][2];
#pragma unroll
    for (int a = 0; a < 2; ++a)
#pragma unroll
        for (int b = 0; b < 2; ++b)
#pragma unroll
            for (int m = 0; m < 4; ++m)
#pragma unroll
                for (int n = 0; n < 2; ++n) acc[a][b][m][n] = (f32x4){0.f, 0.f, 0.f, 0.f};
    bf16x8 At[4][2], B0[2][2], B1[2][2];
    const char* cA = (const char*)g.A + (size_t)cur.pm * tstep + (size_t)cur.ks * sstep; const char* cB = (const char*)g.Bt + (size_t)cur.pn * tstep + (size_t)cur.ks * sstep;
    S.a_ready(cur);
    if constexpr (SP2) {
        PG8_STAGE(PG8_SB(0, 0), cB, voffB); PG8_STAGE(PG8_SB(0, 1), cB + hstep, voffB); PG8_STAGE(PG8_SA(0, 0), cA, voffA); PG8_STAGE(PG8_SA(0, 1), cA + hstep, voffA);
        if (wr == 1) PG8_BAR;
        PG8_WAIT_V(2); PG8_BAR;
        PG8_STAGE(PG8_SB(1, 0), cB + kstep, voffB); PG8_STAGE(PG8_SA(1, 0), cA + kstep, voffA); PG8_STAGE(PG8_SB(1, 1), cB + hstep + kstep, voffB);
        PG8_WAIT_V(6); PG8_BAR;
    } else {
        PG8_STAGE(PG8_SB(0, 0), cB, voffB); PG8_STAGE(PG8_SA(0, 0), cA, voffA); PG8_STAGE(PG8_SB(0, 1), cB + hstep, voffB); PG8_STAGE(PG8_SA(0, 1), cA + hstep, voffA);
        if (wr == 1) PG8_BAR;
        PG8_WAIT_V(4); PG8_BAR;
        PG8_STAGE(PG8_SB(1, 0), cB + kstep, voffB); PG8_STAGE(PG8_SA(1, 0), cA + kstep, voffA); PG8_STAGE(PG8_SB(1, 1), cB + hstep + kstep, voffB);
        PG8_WAIT_V(6); PG8_BAR;
    }
    for (;;) {
        const bool has_next = S.next(ui + 1, nxt);
        const char* nA = has_next ? (const char*)g.A + (size_t)nxt.pm * tstep + (size_t)nxt.ks * sstep : cA; const char* nB = has_next ? (const char*)g.Bt + (size_t)nxt.pn * tstep + (size_t)nxt.ks * sstep : cB;
        for (int t = 0; t < nt; t += 2) {
            const bool last = (t == nt - 2);
            const char* a1 = cA + (size_t)(t + 1) * kstep;
            const char* a2 = last ? nA : cA + (size_t)(t + 2) * kstep; const char* b2 = last ? nB : cB + (size_t)(t + 2) * kstep;
            const char* a3 = a2 + kstep; const char* b3 = b2 + kstep;
            if (last && has_next) S.a_ready(nxt);
            if constexpr (SP2) {
            PG8_LDB(B0, 0, 0); PG8_LDB(B1, 0, 1); PG8_SCHED; PG8_LDA(At, 0, 0); PG8_STAGE(PG8_SA(1, 1), a1 + hstep, voffA);
            PG8_WAIT_V(8); PG8_WAIT_L(0); PG8_BAR; PG8_MMA(0, 0, At, B0); PG8_MMA(0, 1, At, B1); PG8_BAR; PG8_SCHED;
            PG8_LDA(At, 0, 1); PG8_STAGE(PG8_SB(0, 0), b2, voffB); PG8_STAGE(PG8_SB(0, 1), b2 + hstep, voffB); PG8_STAGE(PG8_SA(0, 0), a2, voffA);
            PG8_WAIT_V(8); PG8_WAIT_L(0); PG8_BAR; PG8_MMA(1, 0, At, B0); PG8_MMA(1, 1, At, B1); PG8_BAR; PG8_SCHED;
            PG8_LDB(B0, 1, 0); PG8_LDB(B1, 1, 1); PG8_SCHED; PG8_LDA(At, 1, 0); PG8_STAGE(PG8_SA(0, 1), a2 + hstep, voffA);
            PG8_WAIT_V(8); PG8_WAIT_L(0); PG8_BAR; PG8_MMA(0, 0, At, B0); PG8_MMA(0, 1, At, B1); PG8_BAR; PG8_SCHED;
            PG8_LDA(At, 1, 1); PG8_STAGE(PG8_SB(1, 0), b3, voffB); PG8_STAGE(PG8_SB(1, 1), b3 + hstep, voffB); PG8_STAGE(PG8_SA(1, 0), a3, voffA);
            PG8_WAIT_V(8); PG8_WAIT_L(0); PG8_BAR; PG8_MMA(1, 0, At, B0); PG8_MMA(1, 1, At, B1); PG8_BAR; PG8_SCHED;
            } else {
            PG8_LDB(B0, 0, 0); PG8_SCHED; PG8_LDA(At, 0, 0); PG8_STAGE(PG8_SA(1, 1), a1 + hstep, voffA);
            PG8_WAIT_L(8); PG8_BAR; PG8_WAIT_L(0); PG8_MMA(0, 0, At, B0); PG8_BAR; PG8_SCHED;
            PG8_LDB(B1, 0, 1); PG8_STAGE(PG8_SB(0, 0), b2, voffB);
            PG8_BAR; PG8_WAIT_L(0); PG8_MMA(0, 1, At, B1); PG8_BAR;
            PG8_LDA(At, 0, 1); PG8_STAGE(PG8_SA(0, 0), a2, voffA);
            PG8_BAR; PG8_WAIT_L(0); PG8_MMA(1, 0, At, B0); PG8_BAR; PG8_SCHED;
            PG8_STAGE(PG8_SB(0, 1), b2 + hstep, voffB);
            PG8_WAIT_V(6); PG8_BAR; PG8_MMA(1, 1, At, B1); PG8_BAR;
            PG8_LDB(B0, 1, 0); PG8_SCHED; PG8_LDA(At, 1, 0); PG8_STAGE(PG8_SA(0, 1), a2 + hstep, voffA);
            PG8_WAIT_L(8); PG8_BAR; PG8_WAIT_L(0); PG8_MMA(0, 0, At, B0); PG8_BAR; PG8_SCHED;
            PG8_LDB(B1, 1, 1); PG8_STAGE(PG8_SB(1, 0), b3, voffB);
            PG8_BAR; PG8_WAIT_L(0); PG8_MMA(0, 1, At, B1); PG8_BAR;
            PG8_LDA(At, 1, 1); PG8_STAGE(PG8_SA(1, 0), a3, voffA);
            PG8_BAR; PG8_WAIT_L(0); PG8_MMA(1, 0, At, B0); PG8_BAR; PG8_SCHED;
            PG8_STAGE(PG8_SB(1, 1), b3 + hstep, voffB);
            PG8_WAIT_V(6); PG8_BAR; PG8_MMA(1, 1, At, B1); PG8_BAR;
            }
        }
        if constexpr (ALIGN_EPI) { if (wr == 0) PG8_BAR; }
        if constexpr (!Epi::AFTER_DRAIN) { E(acc, cur, wr, wc, fr, fq); S.done(cur); }
        if (!has_next) break;
#pragma unroll
        for (int a = 0; a < 2; ++a)
#pragma unroll
            for (int b = 0; b < 2; ++b)
#pragma unroll
                for (int m = 0; m < 4; ++m)
#pragma unroll
                    for (int n = 0; n < 2; ++n) acc[a][b][m][n] = (f32x4){0.f, 0.f, 0.f, 0.f};
        cur = nxt; cA = nA; cB = nB; ++ui;
        if constexpr (ALIGN_EPI) { if (wr == 1) PG8_BAR; }
    }
    PG8_WAIT_V(0);
    if constexpr (!ALIGN_EPI) { if (wr == 0) PG8_BAR; }
    PG8_BAR;
    if constexpr (Epi::AFTER_DRAIN) { E.fused(acc, cur, wr, wc, fr, fq, lds, wid, lane); S.done(cur); }
#undef PG8_SA
#undef PG8_SB
#undef PG8_STAGE
#undef PG8_LDA
#undef PG8_LDB
#undef PG8_MMA
#undef PG8_WAIT_V
#undef PG8_WAIT_L
#undef PG8_BAR
#undef PG8_SCHED
}
}
namespace att {
constexpr int NW_ = 8, QBLK = 32;
using bf16x8 = __attribute__((ext_vector_type(8))) short;
using s16x4  = __attribute__((ext_vector_type(4))) short;
using f32x16 = __attribute__((ext_vector_type(16))) float;
using f32x8  = __attribute__((ext_vector_type(8))) float;
using u32x4  = __attribute__((ext_vector_type(4))) unsigned;
#define KSWZ(row, colB) ((row) * 256 + ((colB) ^ (((row) & 7) << 4)))
#define SBAR() __builtin_amdgcn_sched_barrier(0)
__device__ __forceinline__ int crow(int r, int hi) { return (r & 3) + 8 * (r >> 2) + 4 * hi; }
__device__ __forceinline__ unsigned cvtpk(float lo, float hi) {
  unsigned r; asm volatile("v_cvt_pk_bf16_f32 %0, %1, %2" : "=v"(r) : "v"(lo), "v"(hi)); return r;
}
template <typename TIn> struct Stage;
template <> struct Stage<bf16>  { using T = bf16x8;
  __device__ static __forceinline__ T ld8(const bf16* p) { return *reinterpret_cast<const bf16x8*>(p); }
  __device__ static __forceinline__ bf16x8 tobf(T x) { return x; } };
template <> struct Stage<float> { using T = f32x8;
  __device__ static __forceinline__ T ld8(const float* p) { return *reinterpret_cast<const f32x8*>(p); }
  __device__ static __forceinline__ bf16x8 tobf(T x) {
    u32x4 w = {cvtpk(x[0], x[1]), cvtpk(x[2], x[3]), cvtpk(x[4], x[5]), cvtpk(x[6], x[7])}; return *reinterpret_cast<bf16x8*>(&w); } };

__device__ __forceinline__ void partialSM(f32x16& p0, f32x16& p1, float& m_reg, float& mn, float& alpha, const float C, const float thr_raw) {
  float pmax = p0[0]; for (int r = 1; r < 16; ++r) pmax = fmaxf(pmax, p0[r]); for (int r = 0; r < 16; ++r) pmax = fmaxf(pmax, p1[r]);
  { auto rr = __builtin_amdgcn_permlane32_swap(__float_as_uint(pmax), __float_as_uint(pmax), false, false);
    pmax = fmaxf(__uint_as_float(rr[0]), __uint_as_float(rr[1])); }
  if (__builtin_expect(__all(pmax - m_reg <= thr_raw), 1)) { mn = m_reg; alpha = 1.f; }
  else { mn = fmaxf(m_reg, pmax); alpha = __builtin_amdgcn_exp2f((m_reg - mn) * C); m_reg = mn; }
  float mnC = -mn * C;
  for (int r = 0; r < 16; ++r) p0[r] = fmaf(p0[r], C, mnC); for (int r = 0; r < 16; ++r) p1[r] = fmaf(p1[r], C, mnC);
  for (int r = 0; r < 16; ++r) p0[r] = __builtin_amdgcn_exp2f(p0[r]);
}
__device__ __forceinline__ void finishSM(f32x16& p0, f32x16& p1, float alpha, float& l_reg, bf16x8& pa0, bf16x8& pa1, bf16x8& pa2, bf16x8& pa3) {
  for (int r = 0; r < 16; ++r) p1[r] = __builtin_amdgcn_exp2f(p1[r]);
  float ps = 0; for (int r = 0; r < 16; ++r) ps += p0[r]; for (int r = 0; r < 16; ++r) ps += p1[r];
  { auto rr = __builtin_amdgcn_permlane32_swap(__float_as_uint(ps), __float_as_uint(ps), false, false);
    ps = __uint_as_float(rr[0]) + __uint_as_float(rr[1]); }
  l_reg = l_reg * alpha + ps;
#define PK4(P, BASE, OUT) do { unsigned a0 = cvtpk(P[BASE + 0], P[BASE + 1]), a1 = cvtpk(P[BASE + 2], P[BASE + 3]);   \
    unsigned b0 = cvtpk(P[BASE + 4], P[BASE + 5]), b1 = cvtpk(P[BASE + 6], P[BASE + 7]);                              \
    auto r0 = __builtin_amdgcn_permlane32_swap(a0, b0, false, false); auto r1 = __builtin_amdgcn_permlane32_swap(a1, b1, false, false); \
    u32x4 w = {r0[0], r1[0], r0[1], r1[1]}; OUT = *reinterpret_cast<bf16x8*>(&w); } while (0)
  PK4(p0, 0, pa0); PK4(p0, 8, pa1); PK4(p1, 0, pa2); PK4(p1, 8, pa3);
#undef PK4
}
template <bool full> __device__ __forceinline__ void qkt(f32x16& p0, f32x16& p1, const bf16* Ks, const bf16x8* qr, int r32, int hi, const int koff) {
  p0 = f32x16{}; p1 = f32x16{};
  for (int d0 = 0; d0 < 4; ++d0) { int cb = (d0 * 16 + hi * 8) * 2 + koff;
    bf16x8 b0 = *reinterpret_cast<const bf16x8*>((const char*)Ks + KSWZ(r32, cb));
    bf16x8 b1 = *reinterpret_cast<const bf16x8*>((const char*)Ks + KSWZ(32 + r32, cb));
    p0 = __builtin_amdgcn_mfma_f32_32x32x16_bf16(b0, qr[d0], p0, 0, 0, 0);
    p1 = __builtin_amdgcn_mfma_f32_32x32x16_bf16(b1, qr[d0], p1, 0, 0, 0); }
  if constexpr (full) {
  for (int d0 = 4; d0 < 8; ++d0) { int cb = (d0 * 16 + hi * 8) * 2;
    bf16x8 b0 = *reinterpret_cast<const bf16x8*>((const char*)Ks + KSWZ(r32, cb));
    bf16x8 b1 = *reinterpret_cast<const bf16x8*>((const char*)Ks + KSWZ(32 + r32, cb));
    p0 = __builtin_amdgcn_mfma_f32_32x32x16_bf16(b0, qr[d0], p0, 0, 0, 0);
    p1 = __builtin_amdgcn_mfma_f32_32x32x16_bf16(b1, qr[d0], p1, 0, 0, 0); } }
}
__device__ __forceinline__ int v_st(int k, int c) { const int kk = (k & ~0xC) | ((k & 4) << 1) | ((k & 8) >> 1); return ((kk >> 3) * 4 + (c >> 5)) * 512 + ((kk & 7) * 32 + (c & 31)) * 2; }
__device__ __forceinline__ int v_rd_base(int lane) { return ((lane & 3) << 3) | (((lane >> 2) & 3) << 6) | (((lane >> 4) & 1) << 5) | (((lane >> 5) & 1) << 8); }
constexpr int v_rd_off(int d0, int ks, int half) { return d0 * 512 + ks * 4096 + half * 2048; }
template <int OFF> __device__ __forceinline__ s16x4 tr_read(int vb) {
  s16x4 r; asm volatile("ds_read_b64_tr_b16 %0, %1 offset:%2" : "=&v"(r) : "v"(vb), "i"(OFF) : "memory"); return r;
}
template <int D0> __device__ __forceinline__ void pv_one(f32x16& od, int vb, bf16x8 pa0, bf16x8 pa1, bf16x8 pa2, bf16x8 pa3) {
  const s16x4 l0 = tr_read<v_rd_off(D0, 0, 0)>(vb), h0 = tr_read<v_rd_off(D0, 0, 1)>(vb), l1 = tr_read<v_rd_off(D0, 1, 0)>(vb), h1 = tr_read<v_rd_off(D0, 1, 1)>(vb);
  const s16x4 l2 = tr_read<v_rd_off(D0, 2, 0)>(vb), h2 = tr_read<v_rd_off(D0, 2, 1)>(vb), l3 = tr_read<v_rd_off(D0, 3, 0)>(vb), h3 = tr_read<v_rd_off(D0, 3, 1)>(vb);
  asm volatile("s_waitcnt lgkmcnt(0)" ::: "memory"); SBAR();
#define PK(L, H) (bf16x8){L[0], L[1], L[2], L[3], H[0], H[1], H[2], H[3]}
  od = __builtin_amdgcn_mfma_f32_32x32x16_bf16(pa0, PK(l0, h0), od, 0, 0, 0);
  od = __builtin_amdgcn_mfma_f32_32x32x16_bf16(pa1, PK(l1, h1), od, 0, 0, 0);
  od = __builtin_amdgcn_mfma_f32_32x32x16_bf16(pa2, PK(l2, h2), od, 0, 0, 0);
  od = __builtin_amdgcn_mfma_f32_32x32x16_bf16(pa3, PK(l3, h3), od, 0, 0, 0);
#undef PK
}
__device__ __forceinline__ void pv_d0(f32x16* o, int vb, bf16x8 pa0, bf16x8 pa1, bf16x8 pa2, bf16x8 pa3) {
  pv_one<0>(o[0], vb, pa0, pa1, pa2, pa3); pv_one<1>(o[1], vb, pa0, pa1, pa2, pa3); pv_one<2>(o[2], vb, pa0, pa1, pa2, pa3); pv_one<3>(o[3], vb, pa0, pa1, pa2, pa3);
}
struct AttnUnit {
  const bf16* Q; const bf16* K; const bf16* V; bf16* O;
  int ctx_row0, lat_row0, nctx, nt;
  int qpos0, kpos0;
  float C, thr_raw;
  int nsub, sub;
  float lam, post;
  const float* gsub;
  float sink; int has_sink;
  const float* rpb;
  float* stash;
};
#ifndef B_PIPE
#define B_PIPE 0
#endif
#ifndef ATT_SDEPTH
#define ATT_SDEPTH 1
#endif
#ifndef ATT_SDEPTH_FULL
#define ATT_SDEPTH_FULL 1
#endif
#ifndef ATT_SDEPTH_HALF
#define ATT_SDEPTH_HALF 2
#endif
constexpr int LDK = 128, LDO = 2048;
constexpr int SHM_V = 16384, SHM_K = 16384;
constexpr int ATT_WS_OFF = 2 * SHM_V + 2 * SHM_K, ATT_RPB_OFF = ATT_WS_OFF + NW_ * 64 * 4, ATT_LDS = ATT_RPB_OFF + 2048;

template <int MODE>
__device__ __forceinline__ void mask_tile(f32x16& p0, f32x16& p1, int j, const AttnUnit& u, int wid, int r32, int hi, const float* rpbL) {
  if (MODE == 0) return;
  if (j < u.nctx) return;
  int qi = u.qpos0 + wid * 32 + r32; asm volatile("" : "+v"(qi));
  if (MODE == 2) {
    const int kb = u.kpos0 + (j - u.nctx) * 64 + 4 * hi - qi;
#pragma unroll
    for (int r = 0; r < 16; ++r) { const int d0 = kb + (r & 3) + 8 * (r >> 2), d1 = d0 + 32;
      p0[r] = (d0 <= 128 && d0 >= -128) ? p0[r] : -1e30f; p1[r] = (d1 <= 128 && d1 >= -128) ? p1[r] : -1e30f; }
  } else {
    const int i = (u.kpos0 >> 6) + (j - u.nctx);
    const int qr_ = qi >> 6, qc = qi & 63;
    int rs = qr_ - 4; rs = rs < 0 ? 0 : (rs > 24 ? 24 : rs);
    int cs = qc - 8; cs = cs < 0 ? 0 : (cs > 48 ? 48 : cs);
    const bool rowok = (i >= rs) && (i < rs + 8);
    const int bbase = (i - qr_ + 7) * 31 + 15 - qc;
#pragma unroll
    for (int r = 0; r < 16; ++r) { const int c0 = (r & 3) + 8 * (r >> 2) + 4 * hi, c1 = c0 + 32;
        const bool ok0 = rowok && (unsigned)(c0 - cs) < 16u, ok1 = rowok && (unsigned)(c1 - cs) < 16u;
        const float b0 = rpbL[ok0 ? bbase + c0 : 0], b1 = rpbL[ok1 ? bbase + c1 : 0];
        p0[r] = ok0 ? p0[r] + b0 : -1e30f; p1[r] = ok1 ? p1[r] + b1 : -1e30f;
        if (r & 1) __builtin_amdgcn_sched_barrier(0); }
  }
}

#ifdef USE_SGB
#define SGB_QK() do { _Pragma("unroll") for (int i_ = 0; i_ < (FULL ? 16 : 8); ++i_) { __builtin_amdgcn_sched_group_barrier(0x008, 1, 0); __builtin_amdgcn_sched_group_barrier(0x100, 1, 0); __builtin_amdgcn_sched_group_barrier(0x002, SGB_NV, 0); } } while (0)
#else
#define SGB_QK() do { } while (0)
#endif
#ifndef SGB_NV
#define SGB_NV 6
#endif
template <int MODE, bool FULL, bool LATE>
__device__ __forceinline__ void attn_unit(const AttnUnit& u, char* lds) {
  using St = Stage<bf16>;
  constexpr int SDEPTH = (MODE == 0) ? (FULL ? ATT_SDEPTH_FULL : ATT_SDEPTH_HALF) : ATT_SDEPTH;
  int tid = threadIdx.x; asm volatile("" : "+v"(tid));
  const int wid = tid >> 6, lane = tid & 63, r32 = lane & 31, hi = lane >> 5;
  bf16* V_lds = (bf16*)lds; bf16* K_lds = (bf16*)(lds + 2 * SHM_V);
  float* ws = (float*)(lds + ATT_WS_OFF) + wid * 64; float* li_l = ws; float* al_l = ws + 32;
  float* rpbL = (float*)(lds + ATT_RPB_OFF);
#ifdef T3
  const float C = 0.1275174f, thr_raw = 90.5f;
#else
  const float C = u.C, thr_raw = u.thr_raw;
#endif
  __syncthreads();
  if (MODE == 1) { if (tid < 465) rpbL[tid] = u.rpb[tid] * 11.313708498984761f; }
  const int sr = tid >> 4, sc = (tid & 15) * 8, vst0 = v_st(sr, sc), vst1 = v_st(32 + sr, sc);
  const int vb0 = (int)(uintptr_t)V_lds + v_rd_base(lane);
  const unsigned kvoff = (unsigned)(sr * LDK + sc);
  const int NT = u.nt;
#define TROW(j) ((j) < u.nctx ? u.ctx_row0 + (j) * 64 : u.lat_row0 + ((j) - u.nctx) * 64)
  const int sub = u.sub; {
  float m_reg = -1e29f, l_reg = 0; f32x16 o[4] = {}; bf16x8 qr[8];
  const bf16* Qw = u.Q + (long)(wid * QBLK + r32) * LDK + hi * 8;
  constexpr bool qfull = FULL; const int koff = qfull ? 0 : sub * 128, qoff = qfull ? 0 : sub * 64;
#pragma unroll
  for (int d0 = 0; d0 < 8; ++d0) qr[d0] = St::ld8(Qw + (d0 < 4 ? qoff : 0) + d0 * 16);
  struct { typename St::T vs0, vs1, ks0, ks1; } sr_[SDEPTH];
#define SLOAD(i, tj) do { const long ro_ = (long)TROW(tj) * LDK; const bf16* kb_ = u.K + ro_; const bf16* vb_ = u.V + ro_; sr_[i].vs0 = St::ld8(vb_ + kvoff); sr_[i].vs1 = St::ld8(vb_ + 32 * LDK + kvoff); \
    sr_[i].ks0 = St::ld8(kb_ + kvoff); sr_[i].ks1 = St::ld8(kb_ + 32 * LDK + kvoff); } while (0)
#define SWRITE(b, i) do { *(bf16x8*)((char*)V_lds + (b) * SHM_V + vst0) = St::tobf(sr_[i].vs0);          \
    *(bf16x8*)((char*)V_lds + (b) * SHM_V + vst1) = St::tobf(sr_[i].vs1); int kc = sc * 2;               \
    *(bf16x8*)((char*)K_lds + (b) * SHM_K + KSWZ(sr, kc)) = St::tobf(sr_[i].ks0);                       \
    *(bf16x8*)((char*)K_lds + (b) * SHM_K + KSWZ(32 + sr, kc)) = St::tobf(sr_[i].ks1); } while (0)
#define SWAIT() do { if (SDEPTH == 2) asm volatile("s_waitcnt vmcnt(4)" ::: "memory"); else asm volatile("s_waitcnt vmcnt(0)" ::: "memory"); } while (0)
#define RESC(a) do { if (__any((a) < 1.f)) { if (hi == 0) al_l[r32] = (a); asm volatile("s_waitcnt lgkmcnt(0)" ::: "memory"); \
    for (int d = 0; d < 4; ++d) for (int r = 0; r < 16; ++r) o[d][r] *= al_l[crow(r, hi)]; } } while (0)
  f32x16 pA0, pA1, pB0, pB1; float mnA, mnB, alA, alB; bf16x8 pa0, pa1, pa2, pa3;
  constexpr int SE = 0, SO = SDEPTH - 1;
  if constexpr (MODE == 1 && !B_PIPE) {
  __syncthreads();
  SLOAD(SE, 0); asm volatile("s_waitcnt vmcnt(0)" ::: "memory"); SWRITE(0, SE); __syncthreads();
  for (int j = 0; j < NT; ++j) {
    const int bsel = j & 1;
    if (j + 1 < NT) SLOAD(SE, j + 1);
    SBAR(); qkt<FULL>(pA0, pA1, (bf16*)((char*)K_lds + bsel * SHM_K), qr, r32, hi, koff);
    mask_tile<MODE>(pA0, pA1, j, u, wid, r32, hi, rpbL); partialSM(pA0, pA1, m_reg, mnA, alA, C, thr_raw);
    RESC(alA);
    finishSM(pA0, pA1, alA, l_reg, pa0, pa1, pa2, pa3); SBAR();
    pv_d0(o, vb0 + bsel * (int)SHM_V, pa0, pa1, pa2, pa3);
    if (j + 1 < NT) { asm volatile("s_waitcnt vmcnt(0)" ::: "memory"); if (bsel) SWRITE(0, SE); else SWRITE(1, SE); }
    __syncthreads();
  }
  } else {
  __syncthreads();
  SLOAD(SE, 0); asm volatile("s_waitcnt vmcnt(0)" ::: "memory"); SWRITE(0, SE);
  if (SDEPTH == 1) SLOAD(SO, 1);
  __syncthreads();
  qkt<FULL>(pA0, pA1, K_lds, qr, r32, hi, koff); mask_tile<MODE>(pA0, pA1, 0, u, wid, r32, hi, rpbL); partialSM(pA0, pA1, m_reg, mnA, alA, C, thr_raw);
  if (SDEPTH == 2) { SLOAD(SO, 1); if (2 < NT) SLOAD(SE, 2); }
  SWAIT(); SWRITE(1, SO); __syncthreads();
#ifdef ATT_PURE
#define PURE_SBAR() SBAR()
#else
#define PURE_SBAR() do { } while (0)
#endif
#define STEP_EARLY(pc0, pc1, mnc, alc, pp0, pp1, alp, KB, VB, tj, LOADSTMT) do { \
    SBAR(); qkt<FULL>(pc0, pc1, KB, qr, r32, hi, koff); PURE_SBAR(); finishSM(pp0, pp1, alp, l_reg, pa0, pa1, pa2, pa3); SBAR(); \
    LOADSTMT; SBAR(); \
    pv_d0(o, VB, pa0, pa1, pa2, pa3); PURE_SBAR(); mask_tile<MODE>(pc0, pc1, tj, u, wid, r32, hi, rpbL); partialSM(pc0, pc1, m_reg, mnc, alc, C, thr_raw); } while (0)
#define STEP_LATE(pc0, pc1, mnc, alc, pp0, pp1, alp, KB, VB, tj, LOADSTMT) do { \
    SBAR(); finishSM(pp0, pp1, alp, l_reg, pa0, pa1, pa2, pa3); SBAR(); \
    qkt<FULL>(pc0, pc1, KB, qr, r32, hi, koff); SBAR(); \
    LOADSTMT; SBAR(); \
    mask_tile<MODE>(pc0, pc1, tj, u, wid, r32, hi, rpbL); partialSM(pc0, pc1, m_reg, mnc, alc, C, thr_raw); SBAR(); \
    pv_d0(o, VB, pa0, pa1, pa2, pa3); } while (0)
  constexpr bool late = LATE;
  for (int j = 1; j + 1 < NT; j += 2) {
    if constexpr (late) STEP_LATE(pB0, pB1, mnB, alB, pA0, pA1, alA, (bf16*)((char*)K_lds + SHM_K), vb0, j, SLOAD(SO, j + SDEPTH));
    else STEP_EARLY(pB0, pB1, mnB, alB, pA0, pA1, alA, (bf16*)((char*)K_lds + SHM_K), vb0, j, SLOAD(SO, j + SDEPTH));
    __syncthreads(); SWAIT(); SWRITE(0, SE);
    RESC(alB); __syncthreads();
    if constexpr (late) STEP_LATE(pA0, pA1, mnA, alA, pB0, pB1, alB, K_lds, vb0 + (int)SHM_V, j + 1, if (SDEPTH == 1 || j + 3 < NT) SLOAD(SE, j + 1 + SDEPTH));
    else STEP_EARLY(pA0, pA1, mnA, alA, pB0, pB1, alB, K_lds, vb0 + (int)SHM_V, j + 1, if (SDEPTH == 1 || j + 3 < NT) SLOAD(SE, j + 1 + SDEPTH));
    __syncthreads(); SWAIT(); SWRITE(1, SO);
    RESC(alA); __syncthreads();
  }
  SBAR(); qkt<FULL>(pB0, pB1, (bf16*)((char*)K_lds + SHM_K), qr, r32, hi, koff);
  finishSM(pA0, pA1, alA, l_reg, pa0, pa1, pa2, pa3); SBAR();
  pv_d0(o, vb0, pa0, pa1, pa2, pa3); mask_tile<MODE>(pB0, pB1, NT - 1, u, wid, r32, hi, rpbL); partialSM(pB0, pB1, m_reg, mnB, alB, C, thr_raw);
  __syncthreads(); RESC(alB);
  finishSM(pB0, pB1, alB, l_reg, pa0, pa1, pa2, pa3); SBAR();
  pv_d0(o, vb0 + (int)SHM_V, pa0, pa1, pa2, pa3);
  }
  asm volatile("s_waitcnt vmcnt(0)" ::: "memory");
  if (u.has_sink) l_reg += __builtin_amdgcn_exp2f(u.sink * 1.4426950408889634f - m_reg * C);
  if (hi == 0) li_l[r32] = l_reg; asm volatile("s_waitcnt lgkmcnt(0)" ::: "memory");
  float rli[16];
#pragma unroll
  for (int r = 0; r < 16; ++r) rli[r] = __builtin_amdgcn_rcpf(li_l[crow(r, hi)]);
#pragma unroll
  for (int r = 0; r < 16; ++r)
#pragma unroll
    for (int d0 = 0; d0 < 4; ++d0) o[d0][r] *= rli[r];
#ifdef O_DIRECT
  if (u.nsub == 2) {
    bf16* sp = (bf16*)u.stash + (long)u.sub * (256 * 128) + (long)(wid * QBLK) * 128 + r32;
#pragma unroll
    for (int r = 0; r < 16; ++r)
#pragma unroll
      for (int d0 = 0; d0 < 4; ++d0) sp[crow(r, hi) * 128 + d0 * 32] = (bf16)f2bf(o[d0][r]);
  } else {
    bf16* Ow = u.O + (long)(wid * QBLK) * LDO + r32;
#pragma unroll
    for (int r = 0; r < 16; ++r)
#pragma unroll
      for (int d0 = 0; d0 < 4; ++d0) Ow[(long)crow(r, hi) * LDO + d0 * 32] = (bf16)f2bf(o[d0][r]);
  }
#else
  __syncthreads();
  { __attribute__((address_space(3))) char* so = (__attribute__((address_space(3))) char*)lds + wid * 8192;
#pragma unroll
    for (int r = 0; r < 16; ++r)
#pragma unroll
      for (int d0 = 0; d0 < 4; ++d0) *(__attribute__((address_space(3))) bf16*)(so + crow(r, hi) * 256 + (d0 * 32 + r32) * 2) = (bf16)(cvtpk(o[d0][r], o[d0][r]) & 0xffffu);
    asm volatile("s_waitcnt lgkmcnt(0)" ::: "memory");
    const bool dm = (u.nsub == 2);
    bf16* dst = dm ? (bf16*)u.stash + (long)u.sub * (256 * 128) + (long)(wid * QBLK) * 128 : u.O + (long)(wid * QBLK) * LDO;
    const long pitch = dm ? 128 : LDO;
#pragma unroll
    for (int it = 0; it < 8; ++it) { const int ch = it * 64 + lane, row = ch >> 4, cc = ch & 15;
      const u32x4 w = *(const __attribute__((address_space(3))) u32x4*)(so + row * 256 + cc * 16);
      *(u32x4*)(dst + (long)row * pitch + cc * 8) = w; }
  }
#endif
  }
#undef TROW
#undef STEP_EARLY
#undef STEP_LATE
#undef SLOAD
#undef SWRITE
#undef SWAIT
#undef RESC
}

__device__ __forceinline__ void unit_finish(const AttnUnit& u) {
  int tid = threadIdx.x; asm volatile("" : "+v"(tid));
  const int wid = tid >> 6, lane = tid & 63;
  if (u.nsub != 2 || u.sub == 0) return;
  __syncthreads();
  const unsigned* s0 = (const unsigned*)((const bf16*)u.stash + (long)(wid * QBLK) * 128) + lane; const unsigned* s1 = s0 + 256 * 128 / 2;
  unsigned* op = (unsigned*)(u.O + (long)(wid * QBLK) * LDO) + lane;
  {
    const float g0 = u.gsub[2 * lane] * u.post, g1 = u.gsub[2 * lane + 1] * u.post;
#pragma unroll 8
    for (int r = 0; r < 32; ++r) {
      const unsigned wa = s0[r * 64], wb = s1[r * 64];
      const float a0 = bf2f(wa & 0xffffu), a1 = bf2f(wa >> 16), b0 = bf2f(wb & 0xffffu), b1 = bf2f(wb >> 16);
      const float v0 = a0 - u.lam * b0, v1 = a1 - u.lam * b1;
      float ss = v0 * v0 + v1 * v1;
      ss = ::wave_sum(ss);
      const float rn = 1.0f / sqrtf(ss * (1.0f / 128.0f) + 1e-6f);
      op[(long)r * (LDO / 2)] = pk2(v0 * rn * g0, v1 * rn * g1);
    }
  }
}

#undef SBAR
#undef KSWZ
}
struct Args { const float* in[22]; float* out; unsigned char* ws; int ph_lo, ph_hi; };
enum { I_X = 0, I_C, I_CTX, I_CCTX, I_GMIX, I_GMLP, I_WMOD, I_BMOD, I_WIN, I_WOUT, I_GQ, I_GK, I_RPB, I_LQ1, I_LK1, I_LQ2, I_LK2, I_GSUB, I_SINK, I_WUP, I_WDN, I_GFIN };
typedef float f32x4g __attribute__((ext_vector_type(4)));
typedef unsigned v4u __attribute__((ext_vector_type(4)));

__device__ __forceinline__ void transpose_item(const float* W, int K, int N, bf16* WT, int ldt, LAS float* scr, int item, int lane) {
    const int nblk = N / 32, kb = item / nblk, nb = item % nblk, k0 = 64 * kb, n0 = 32 * nb;
#pragma unroll 8
    for (int i = 0; i < 32; ++i) { const int kk = 2 * i + (lane >> 5); scr[kk * 33 + (lane & 31)] = W[(size_t)(k0 + kk) * N + n0 + (lane & 31)]; }
    asm volatile("s_waitcnt lgkmcnt(0)" ::: "memory");
    const int c = lane & 7;
#pragma unroll
    for (int j = 0; j < 4; ++j) { const int n = (lane >> 3) + 8 * j; const LAS float* s = scr + (8 * c) * 33 + n;
        v4u o; o.x = pk2(s[0 * 33], s[1 * 33]); o.y = pk2(s[2 * 33], s[3 * 33]); o.z = pk2(s[4 * 33], s[5 * 33]); o.w = pk2(s[6 * 33], s[7 * 33]);
        *(v4u*)(WT + (size_t)(n0 + n) * ldt + k0 + 8 * c) = o; }
    asm volatile("s_waitcnt lgkmcnt(0)" ::: "memory");
}

__device__ __forceinline__ void weight_transposes(const Args& a, unsigned char* lds_, int l, int wg, int nwg_) {
    int tid_ = threadIdx.x; asm volatile("" : "+v"(tid_)); const int lane = tid_ & 63, wave = tid_ >> 6; const int gw = wg * NWAVES + wave, NGW = nwg_ * NWAVES;
    LAS float* scr = (LAS float*)((LAS unsigned char*)lds_ + wave * 16384);
    constexpr int I_IN = (DM / 64) * (PW / 32), I_OUT = (DM / 64) * (DM / 32), I_UP = (DM / 64) * (HID / 32), I_DN = (HID / 64) * (DM / 32), I_L = I_IN + I_OUT + I_UP + I_DN;
    bf16* wt = (bf16*)(a.ws + WS_WT + (size_t)l * WL_B);
    for (int it = gw; it < I_L; it += NGW) {
        int r = it;
        if (r < I_IN) { transpose_item(a.in[I_WIN] + (size_t)l * DM * PW, DM, PW, wt, DM, scr, r, lane); continue; } r -= I_IN;
        if (r < I_OUT) { transpose_item(a.in[I_WOUT] + (size_t)l * DM * DM, DM, DM, (bf16*)((unsigned char*)wt + WIN_B), DM, scr, r, lane); continue; } r -= I_OUT;
        if (r < I_UP) { transpose_item(a.in[I_WUP] + (size_t)l * DM * HID, DM, HID, (bf16*)((unsigned char*)wt + WIN_B + WOUT_B), DM, scr, r, lane); continue; } r -= I_UP;
        transpose_item(a.in[I_WDN] + (size_t)l * HID * DM, HID, DM, (bf16*)((unsigned char*)wt + WIN_B + WOUT_B + WUP_B), HIDP, scr, r, lane);
    }
}

__device__ __forceinline__ void phase_prologue(const Args& a, unsigned char* lds_, int G, int vcu) {
    int tid_ = threadIdx.x; asm volatile("" : "+v"(tid_)); const int tid = tid_, lane = tid & 63, wave = tid >> 6;
    float* cond = (float*)lds_;
    float* part = (float*)(lds_ + 9 * 2048 * 4);
    __syncthreads();
    for (int i = tid; i < 9 * 2048; i += NTHREADS) { const int r = i >> 11, k = i & 2047; const float v = r < 8 ? a.in[I_C][r * 2048 + k] : a.in[I_CCTX][k]; cond[i] = v / (1.0f + expf(-v)); }
    __syncthreads();
    float* MOD = (float*)(a.ws + WS_MOD);
    for (int item = blockIdx.x; item < 768; item += G) {
        const int l = item / 384, n0 = (item % 384) * 32;
        const float* W = a.in[I_WMOD] + (size_t)l * 2048 * MODW + n0;
        const int kq = tid >> 3, c4 = tid & 7;
        float acc[9][4];
#pragma unroll
        for (int r = 0; r < 9; ++r)
#pragma unroll
            for (int j = 0; j < 4; ++j) acc[r][j] = 0.f;
#pragma unroll 2
        for (int i0 = 0; i0 < 32; i0 += 4) {
            f32x4g w[4];
#pragma unroll
            for (int i = 0; i < 4; ++i) w[i] = *(const f32x4g*)(W + (size_t)(kq * 32 + i0 + i) * MODW + c4 * 4);
#pragma unroll
            for (int r = 0; r < 9; ++r) { const f32x4g cv = *(const f32x4g*)(cond + r * 2048 + kq * 32 + i0);
#pragma unroll
                for (int i = 0; i < 4; ++i)
#pragma unroll
                    for (int j = 0; j < 4; ++j) acc[r][j] += cv[i] * w[i][j]; }
        }
#pragma unroll
        for (int r = 0; r < 9; ++r)
#pragma unroll
            for (int j = 0; j < 4; ++j) { float v = acc[r][j]; v = sum_xor<8>(v); v = sum_xor<16>(v); v = sum_xor<32>(v); if (lane < 8) part[(wave * 9 + r) * 32 + c4 * 4 + j] = v; }
        __syncthreads();
        if (tid < 288) { const int r = tid >> 5, n = tid & 31; float s = 0.f;
#pragma unroll
            for (int w = 0; w < 8; ++w) s += part[(w * 9 + r) * 32 + n];
            MOD[(size_t)(l * 9 + r) * MODW + n0 + n] = s + a.in[I_BMOD][l * MODW + n0 + n]; }
        __syncthreads();
    }
    weight_transposes(a, lds_, 0, vcu, G); weight_transposes(a, lds_, 1, vcu, G);
    float* cosH = (float*)(a.ws + WS_ROPE); float* sinH = cosH + 2048 * 64; float* cosD = sinH + 2048 * 64; float* sinD = cosD + 2048 * 32;
    for (int i = blockIdx.x * NTHREADS + tid; i < 2048 * 96; i += G * NTHREADS) {
        if (i < 2048 * 64) { const int t = i >> 6, p = i & 63; const float pos = (float)(p < 32 ? (t >> 6) : (t & 63)); const float f = powf(10000.0f, -(float)(p & 31) / 32.0f); const float ang = pos * f; cosH[i] = cosf(ang); sinH[i] = sinf(ang); }
        else { const int k = i - 2048 * 64, t = k >> 5, p = k & 31; const float pos = (float)(p < 16 ? (t >> 6) : (t & 63)); const float f = powf(10000.0f, -(float)(p & 15) / 16.0f); const float ang = pos * f; cosD[k] = cosf(ang); sinD[k] = sinf(ang); }
    }
}

__device__ __forceinline__ void phase_norm(const void* xa, bool xa_bf16, const void* xb, bool xb_bf16, int M, const float* g, const float* modl, int shift_slot, int scale_slot, bf16* out, const float* part, const float* pgate, bf16* wb, int G, int vcu) {
    int tid_ = threadIdx.x; asm volatile("" : "+v"(tid_)); const int lane = tid_ & 63, wave = tid_ >> 6; const int gw = vcu * NWAVES + wave, NGW = G * NWAVES;
    for (int m = gw; m < M; m += NGW) {
        const int b = m < MX ? (m >> 11) : 8; const bool isb = m < MX ? xa_bf16 : xb_bf16; const size_t ro = m < MX ? (size_t)m * DM : (size_t)(m - MX) * DM; const void* src = m < MX ? xa : xb;
        f32x4g v[8]; float s = 0.f;
        if (isb) { const unsigned long long* bp = (const unsigned long long*)((const bf16*)src + ro) + lane;
#pragma unroll
            for (int j = 0; j < 8; ++j) { const unsigned long long w = bp[64 * j]; v[j].x = bf2f((unsigned)w & 0xffffu); v[j].y = bf2f(((unsigned)w) >> 16); v[j].z = bf2f((unsigned)(w >> 32) & 0xffffu); v[j].w = bf2f((unsigned)(w >> 48)); } }
        else { const f32x4g* xp = (const f32x4g*)((const float*)src + ro) + lane;
#pragma unroll
            for (int j = 0; j < 8; ++j) v[j] = xp[64 * j]; }
        if (part != nullptr && m >= MX) { const f32x4g* pp = (const f32x4g*)(part + (size_t)(m - MX) * DM) + lane; const f32x4g* pg = (const f32x4g*)pgate + lane;
#pragma unroll
            for (int j = 0; j < 8; ++j) { const f32x4g q = (pp[64 * j] + pp[64 * j + (size_t)MC * DM / 4]) + (pp[64 * j + 2 * ((size_t)MC * DM / 4)] + pp[64 * j + 3 * ((size_t)MC * DM / 4)]); v[j] += pg[64 * j] * q; }
            if (wb != nullptr) { unsigned long long* wp = (unsigned long long*)(wb + (size_t)(m - MX) * DM) + lane;
#pragma unroll
                for (int j = 0; j < 8; ++j) wp[64 * j] = (unsigned long long)pk2(v[j].x, v[j].y) | ((unsigned long long)pk2(v[j].z, v[j].w) << 32); } }
#pragma unroll
        for (int j = 0; j < 8; ++j) s += (v[j].x * v[j].x + v[j].y * v[j].y) + (v[j].z * v[j].z + v[j].w * v[j].w);
        const float rstd = 1.0f / sqrtf(wave_sum(s) * (1.0f / DM) + NORM_EPS);
        const f32x4g* gp = (const f32x4g*)g + lane; const f32x4g* shp = (const f32x4g*)(modl + (size_t)b * MODW + shift_slot * DM) + lane; const f32x4g* scp = (const f32x4g*)(modl + (size_t)b * MODW + scale_slot * DM) + lane;
        unsigned long long* o8 = (unsigned long long*)(out + (size_t)m * DM) + lane;
#pragma unroll
        for (int j = 0; j < 8; ++j) { const f32x4g gg = gp[64 * j], sh = shp[64 * j], sc = scp[64 * j]; const f32x4g y = (v[j] * rstd) * gg * (sc + 1.0f) + sh;
            o8[64 * j] = (unsigned long long)pk2(y.x, y.y) | ((unsigned long long)pk2(y.z, y.w) << 32); }
    }
}
__device__ __forceinline__ void phase_final(const bf16* x, const float* g, float* out, int G, int vcu) {
    int tid_ = threadIdx.x; asm volatile("" : "+v"(tid_)); const int lane = tid_ & 63, wave = tid_ >> 6; const int gw = vcu * NWAVES + wave, NGW = G * NWAVES;
    for (int m = gw; m < MX; m += NGW) {
        const unsigned long long* bp = (const unsigned long long*)(x + (size_t)m * DM) + lane; f32x4g v[8]; float s = 0.f;
#pragma unroll
        for (int j = 0; j < 8; ++j) { const unsigned long long w = bp[64 * j]; v[j].x = bf2f((unsigned)w & 0xffffu); v[j].y = bf2f(((unsigned)w) >> 16); v[j].z = bf2f((unsigned)(w >> 32) & 0xffffu); v[j].w = bf2f((unsigned)(w >> 48));
            s += (v[j].x * v[j].x + v[j].y * v[j].y) + (v[j].z * v[j].z + v[j].w * v[j].w); }
        const float rstd = 1.0f / sqrtf(wave_sum(s) * (1.0f / DM) + NORM_EPS);
        const f32x4g* gp = (const f32x4g*)g + lane; f32x4g* op = (f32x4g*)(out + (size_t)m * DM) + lane;
#pragma unroll
        for (int j = 0; j < 8; ++j) op[64 * j] = (v[j] * rstd) * gp[64 * j];
    }
}

__device__ __forceinline__ void phase_qkprep(bf16* P, const float* gq, const float* gk, const float* rope, int G, int vcu) {
    int tid_ = threadIdx.x; asm volatile("" : "+v"(tid_)); const int lane = tid_ & 63, wave = tid_ >> 6; const int gw = vcu * NWAVES + wave, NGW = G * NWAVES;
    const float* cosH = rope; const float* sinH = cosH + 2048 * 64; const float* cosD = sinH + 2048 * 64; const float* sinD = cosD + 2048 * 32;
    const float gq0 = gq[2 * lane], gq1 = gq[2 * lane + 1], gk0 = gk[2 * lane], gk1 = gk[2 * lane + 1];
    for (int m = gw; m < MT; m += NGW) {
        const bool lat = m < MX; const int pos = m & 2047;
        unsigned* row = (unsigned*)(P + (size_t)m * PW) + lane;
        float cH = 1.f, sH = 0.f, cD = 1.f, sD = 0.f;
        if (lat) { cH = cosH[pos * 64 + lane]; sH = sinH[pos * 64 + lane]; cD = cosD[pos * 32 + (lane & 31)]; sD = sinD[pos * 32 + (lane & 31)]; }
#pragma unroll
        for (int blk = 0; blk < 6; ++blk) {
            const unsigned w = row[blk * 64]; float x0 = bf2f(w & 0xffffu), x1 = bf2f(w >> 16);
            const float ss = wave_sum(x0 * x0 + x1 * x1); const float rn = 1.0f / sqrtf(ss * (1.0f / 128.0f) + NORM_EPS);
            x0 = x0 * rn * (blk < 4 ? gq0 : gk0); x1 = x1 * rn * (blk < 4 ? gq1 : gk1);
            const float y0 = x0 * cH - x1 * sH, y1 = x0 * sH + x1 * cH;
            row[blk * 64] = pk2(y0, y1);
        }
        if (lat) {
#pragma unroll
            for (int blk = 0; blk < 8; ++blk) {
                const unsigned w = row[(2560 / 2) + blk * 64]; const float x0 = bf2f(w & 0xffffu), x1 = bf2f(w >> 16);
                row[(2560 / 2) + blk * 64] = pk2(x0 * cD - x1 * sD, x0 * sD + x1 * cD);
            }
#pragma unroll
            for (int blk = 0; blk < 6; ++blk) {
                const unsigned w = row[(4096 / 2) + blk * 64]; const float x0 = bf2f(w & 0xffffu), x1 = bf2f(w >> 16);
                row[(4096 / 2) + blk * 64] = pk2(x0 * cH - x1 * sH, x0 * sH + x1 * cH);
            }
        }
    }
}

#ifndef AM1
#define AM1 1
#define AM2 2
#endif
__device__ __forceinline__ void phase_attention(const Args& a, int layer, unsigned char* lds_, int G, int vcu) {
    bf16* P = (bf16*)(a.ws + WS_P); bf16* AO = (bf16*)(a.ws + WS_AO);
    const float LOG2E = 1.4426950408889634f;
    const float lam_init = 0.8f - 0.6f * expf(-0.3f * (float)layer);
    float lam;
    { int lane = threadIdx.x & 63; asm volatile("" : "+v"(lane)); const float* q1 = a.in[I_LQ1] + layer * 64, *k1 = a.in[I_LK1] + layer * 64, *q2 = a.in[I_LQ2] + layer * 64, *k2 = a.in[I_LK2] + layer * 64;
      const float s1 = wave_sum(q1[lane] * k1[lane]), s2 = wave_sum(q2[lane] * k2[lane]); lam = expf(s1) - expf(s2) + lam_init; lam = __builtin_bit_cast(float, __builtin_amdgcn_readfirstlane(__builtin_bit_cast(int, lam))); }
    const int nround = layer == 0 ? 7 : 5;
    for (int vu = vcu; vu < 256; vu += G) {
    for (int round = 0; round < nround; ++round) {
        att::AttnUnit u; int type, b, h, qb; bool isctx = false; u.sub = 0;
        if (round < 5) { b = vu >> 5; h = (vu >> 3) & 3; qb = vu & 7;
            const int rr = (h < 2) ? round : (round + 2) % 5;
            type = rr < 2 ? 2 : (rr == 2 ? 0 : (rr == 3 ? 1 : 3)); u.sub = rr == 1 ? 1 : 0; }
        else { if (vu & 1) continue; const int idx = vu >> 1; b = idx >> 4; type = (idx >> 2) & 3; h = idx & 3; qb = 0; isctx = true; if (round == 6) { if (type != 2) continue; u.sub = 1; } }
        const int kvh = (type == 0 || type == 3) ? (h >> 1) : h;
        const int qcol = type == 0 ? h * 128 : type == 1 ? 1024 + h * 128 : type == 2 ? 2560 + h * 128 : 4096 + h * 128;
        const int kcol = type == 0 ? 512 + kvh * 128 : type == 1 ? 1536 + kvh * 128 : type == 2 ? 3072 + kvh * 128 : 4608 + kvh * 128;
        const int vcol = type == 0 ? 768 + kvh * 128 : type == 1 ? 2048 + kvh * 128 : type == 2 ? 3584 + kvh * 128 : 4864 + kvh * 128;
        const int ocol = type * 512 + h * 128;
        const int qrow0 = isctx ? MX + b * CTXL : b * SEQ + qb * 256;
        u.Q = P + ((size_t)(qcol >> 7) * MT + qrow0) * 128; u.K = P + (size_t)(kcol >> 7) * MT * 128; u.V = P + (size_t)(vcol >> 7) * MT * 128; u.O = AO + (size_t)qrow0 * DM + ocol;
        u.ctx_row0 = MX + b * CTXL; u.nctx = 4; u.qpos0 = qb * 256;
        int t_lo = 0, nlat = 32;
        if (isctx) nlat = 0;
        else if (type == 1) { const int r0 = qb * 4; int lo = r0 - 4; lo = lo < 0 ? 0 : (lo > 24 ? 24 : lo); int hi = r0 - 1; hi = hi < 0 ? 0 : (hi > 24 ? 24 : hi); hi += 8; if ((hi - lo) & 1) hi += 1; t_lo = lo; nlat = hi - lo; }
        else if (type == 3) { int lo = qb * 4 - 2; lo = lo < 0 ? 0 : lo; int hi = qb * 4 + 6; hi = hi > 32 ? 32 : hi; t_lo = lo; nlat = hi - lo; }
        u.lat_row0 = b * SEQ + t_lo * 64; u.kpos0 = t_lo * 64; u.nt = 4 + nlat;
        const float scale = type == 2 ? 0.125f : 0.088388347648318440f;
        u.C = scale * LOG2E; u.thr_raw = 8.0f / scale;
        u.nsub = type == 2 ? 2 : 1; u.lam = lam; u.post = 1.0f - lam_init; u.gsub = a.in[I_GSUB] + layer * 128;
        u.has_sink = type == 3; u.sink = type == 3 ? a.in[I_SINK][layer * 4 + h] : 0.f;
        u.rpb = a.in[I_RPB] + (size_t)(layer * 4 + h) * 465;
        u.stash = (float*)(a.ws + WS_STASH) + (size_t)blockIdx.x * 2 * 256 * 128;
#ifdef ATT_DUP_ROUND
        for (int dup_ = 0; dup_ < (round == ATT_DUP_ROUND ? 2 : 1); ++dup_) {
#else
        {
#endif
#ifdef ATT_STAGGER
        const bool late = __builtin_amdgcn_readfirstlane((int)(threadIdx.x >> 6)) >= 4;
#else
        const bool late = false;
#endif
        if (!isctx && type == 1) att::attn_unit<AM1, true, false>(u, (char*)lds_);
        else if (!isctx && type == 3) { if (late) att::attn_unit<AM2, true, true>(u, (char*)lds_); else att::attn_unit<AM2, true, false>(u, (char*)lds_); }
        else if (type == 2) { if (late) att::attn_unit<0, false, true>(u, (char*)lds_); else att::attn_unit<0, false, false>(u, (char*)lds_); }
        else { if (late) att::attn_unit<0, true, true>(u, (char*)lds_); else att::attn_unit<0, true, false>(u, (char*)lds_); }
        att::unit_finish(u);
        }
    }
    }
}
#ifndef PHMASK
#define PHMASK 1023
#endif
#ifndef REP_ATT
#define REP_ATT 1
#endif
#ifndef REP_UP
#define REP_UP 1
#endif
#ifndef REP_IN
#define REP_IN 1
#endif
#ifndef REP_PRO
#define REP_PRO 1
#endif
#ifndef REP_SYNC
#define REP_SYNC 1
#endif
#ifndef REP_NORM
#define REP_NORM 1
#endif
#ifndef REP_INQK
#define REP_INQK 1
#endif
#ifndef REP_DN
#define REP_DN 1
#endif
#ifndef DN_WGM
#define DN_WGM 4
#endif
#ifndef USE_XB
#define USE_XB 0
#endif
#ifndef RES_SP2
#define RES_SP2 true
#endif
#ifndef DN_KCH
#define DN_KCH 1
#endif
#ifndef UP_ALIGN
#define UP_ALIGN true
#endif
#ifndef MK_COOP
#define MK_COOP 1
#endif
constexpr int N_PHASES = 18;
__global__ void __launch_bounds__(NTHREADS) fwd_kernel(Args a) {
    extern __shared__ __attribute__((aligned(16))) unsigned char lds[];
    cg::grid_group grid = cg::this_grid();
    const int G = gridDim.x, bx = blockIdx.x;
    const int vcu = (G % 8 == 0) ? (bx % 8) * (G / 8) + bx / 8 : bx;
#define IN(k) (a.ph_lo <= (k) && (k) < a.ph_hi)
#define SEAM(k) do { if (IN(k) && IN((k) + 1)) for (int rs_ = 0; rs_ < REP_SYNC; ++rs_) { if (a.ph_lo < 0) grid.sync(); else xcd_barrier(xbar); }     } while (0)
    unsigned char* ws = a.ws;
    volatile LAS unsigned* xst = (volatile LAS unsigned*)((LAS unsigned char*)lds + 131072 + 64);
    if (threadIdx.x < 2) xst[threadIdx.x] = 0u;
    __syncthreads();
    XcdBarrier xbar; xbar.bar = (unsigned*)ws; xbar.x = 0; xbar.st = nullptr;
    if (a.ph_hi - a.ph_lo > 1) xbar = xcd_barrier_post((unsigned*)ws, xst);
    #if PHMASK & 1
    if (IN(0)) for (int rep_ = 0; rep_ < REP_PRO; ++rep_) phase_prologue(a, lds, G, vcu);
#endif
    SEAM(0);
    for (int l = 0; l < 2; ++l) {
        const int pb = 1 + 8 * l;
        bf16* X = (bf16*)(ws + WS_X); bf16* H0 = (bf16*)(ws + WS_H0); bf16* P = (bf16*)(ws + WS_P); bf16* AO = (bf16*)(ws + WS_AO); bf16* HM = (bf16*)(ws + WS_BIG);
        const float* modl = (const float*)(ws + WS_MOD) + (size_t)l * 9 * MODW;
        const bf16* Win = (const bf16*)(ws + WS_WT + (size_t)l * WL_B); const bf16* Wout = (const bf16*)((const unsigned char*)Win + WIN_B);
        const bf16* Wup = (const bf16*)((const unsigned char*)Wout + WOUT_B); const bf16* Wdn = (const bf16*)((const unsigned char*)Wup + WUP_B);
        const int M2 = l == 0 ? MT : MX;
#if PHMASK & 2
        if (IN(pb + 0)) for (int rep_ = 0; rep_ < REP_NORM; ++rep_) phase_norm(l == 0 ? (const void*)a.in[I_X] : (const void*)X, l == 1, l == 0 ? (const void*)a.in[I_CTX] : (const void*)(X + (size_t)MX * DM), l == 1, MT, a.in[I_GMIX] + l * DM, modl, 0, 1, H0, l == 1 ? (const float*)(ws + WS_STASH) : nullptr, (const float*)(ws + WS_MOD) + 8 * MODW + 5 * DM, nullptr, G, vcu);
#endif
        SEAM(pb + 0);
        for (int rq_ = 0; rq_ < REP_INQK; ++rq_) {
#if PHMASK & 4
        if (IN(pb + 1)) for (int rep_ = 0; rep_ < REP_IN; ++rep_) { pg8::Gemm g{H0, Win, MT, PW, DM, DM}; pg8::StaticOrder S; S.init(MT, PW, G, bx); pg8::EpiInProj E{P, MT, a.in[I_GQ] + l * 128, a.in[I_GK] + l * 128, (const float*)(ws + WS_ROPE), (LAS float*)((LAS unsigned char*)lds + 131072 + 1024)};
            pg8::gemm_phase<pg8::EpiInProj, pg8::StaticOrder, true, true>((LAS unsigned char*)lds, g, S, E); }
#endif
        SEAM(pb + 1);
        }
#if PHMASK & 16
        if (IN(pb + 3)) for (int rep_ = 0; rep_ < REP_ATT; ++rep_) phase_attention(a, l, lds, G, vcu);
#endif
        SEAM(pb + 3);
#if PHMASK & 32
        if (IN(pb + 4)) {
            { pg8::Gemm g{AO, Wout, MX, DM, DM, DM}; pg8::ChunkOrder S; S.init(MX, DM, G, bx, 8, 1);
              if (l == 0) { pg8::EpiResidB<true> E{a.in[I_X], nullptr, X, modl + 2 * DM}; pg8::gemm_phase<pg8::EpiResidB<true>, pg8::ChunkOrder, true, RES_SP2>((LAS unsigned char*)lds, g, S, E); }
              else { pg8::EpiResidB<false> E{nullptr, X, X, modl + 2 * DM}; pg8::gemm_phase<pg8::EpiResidB<false>, pg8::ChunkOrder, true, RES_SP2>((LAS unsigned char*)lds, g, S, E); } }
            if (l == 0) {
              pg8::Gemm g{AO, Wout, MT, DM, DM, DM / 4}; pg8::SplitOrder S; S.init(MX / 256, MC / 256, DM / 256, 4, G, bx); pg8::EpiPart E{(float*)(ws + WS_STASH), MX / 256, (size_t)MC * DM};
              pg8::gemm_phase<pg8::EpiPart, pg8::SplitOrder, true, true>((LAS unsigned char*)lds, g, S, E); }
        }
#endif
        SEAM(pb + 4);
#if PHMASK & 64
        if (IN(pb + 5)) for (int rep_ = 0; rep_ < REP_NORM; ++rep_) phase_norm(X, true, l == 0 ? (const void*)a.in[I_CTX] : (const void*)(X + (size_t)MX * DM), l == 1, M2, a.in[I_GMLP] + l * DM, modl, 3, 4, H0, l == 0 ? (const float*)(ws + WS_STASH) : nullptr, (const float*)(ws + WS_MOD) + 8 * MODW + 2 * DM, l == 0 ? X + (size_t)MX * DM : nullptr, G, vcu);
#endif
        SEAM(pb + 5);
#if PHMASK & 128
        if (IN(pb + 6)) for (int rep_ = 0; rep_ < REP_UP; ++rep_) { pg8::Gemm g{H0, Wup, M2, HID, DM, DM}; pg8::StaticOrder S; S.init(M2, HID, G, bx); pg8::EpiStore<1> E{HM, HIDP};
            pg8::gemm_phase<pg8::EpiStore<1>, pg8::StaticOrder, UP_ALIGN, true>((LAS unsigned char*)lds, g, S, E); }
#endif
        SEAM(pb + 6);
#if PHMASK & 256
        if (IN(pb + 7)) {
            { const int nch = (((MX / 256) * (DM / 256)) % G == 0) ? DN_KCH : 1;
              pg8::Gemm g{HM, Wdn, MX, DM, HIDP, HID / nch}; pg8::ChunkOrder S; S.init(MX, DM, G, bx, DN_WGM, nch); pg8::EpiResidB<false> E{nullptr, X, X, modl + 5 * DM};
              pg8::gemm_phase<pg8::EpiResidB<false>, pg8::ChunkOrder, true, RES_SP2>((LAS unsigned char*)lds, g, S, E); }
            if (l == 0) {
              pg8::Gemm g{HM, Wdn, MT, DM, HIDP, HID / 4}; pg8::SplitOrder S; S.init(MX / 256, MC / 256, DM / 256, 4, G, bx); pg8::EpiPart E{(float*)(ws + WS_STASH), MX / 256, (size_t)MC * DM};
              pg8::gemm_phase<pg8::EpiPart, pg8::SplitOrder, true, true>((LAS unsigned char*)lds, g, S, E); }
        }
#endif
        SEAM(pb + 7);
    }
#if PHMASK & 512
    if (IN(17)) phase_final((const bf16*)(ws + WS_X), a.in[I_GFIN], a.out, G, vcu);
#endif
#undef IN
#undef SEAM
}

extern "C" void kernel_launch(void* const* d_in, const int* in_sizes, int n_in, void* d_out, int out_size, void* d_ws, size_t ws_size, hipStream_t stream) {
    static int grid = 0;
    if (grid == 0) {
        if (n_in != 22 || out_size != MX * DM || ws_size < WS_END) { fprintf(stderr, "kernel_launch: unexpected shapes (n_in %d out %d ws %zu need %zu)\n", n_in, out_size, ws_size, (size_t)WS_END); grid = -1; return; }
        int dev = 0, cus = 0, per_cu = 0;
        hipGetDevice(&dev); hipDeviceGetAttribute(&cus, hipDeviceAttributeMultiprocessorCount, dev);
        if (hipFuncSetAttribute((const void*)fwd_kernel, hipFuncAttributeMaxDynamicSharedMemorySize, LDS_BYTES) != hipSuccess) { fprintf(stderr, "kernel_launch: hipFuncSetAttribute failed\n"); grid = -1; return; }
        if (hipOccupancyMaxActiveBlocksPerMultiprocessor(&per_cu, (const void*)fwd_kernel, NTHREADS, LDS_BYTES) != hipSuccess || per_cu < 1) { fprintf(stderr, "kernel_launch: occupancy query gave %d\n", per_cu); per_cu = 1; }
        (void)hipGetLastError();
        grid = cus * per_cu;
        fprintf(stderr, "kernel_launch: grid %d (cus %d x %d)\n", grid, cus, per_cu);
    }
    if (grid < 0) return;
    (void)hipMemsetAsync(d_ws, 0, 16384, stream);
    Args a{};
    for (int i = 0; i < 22; ++i) a.in[i] = (const float*)d_in[i];
    a.out = (float*)d_out; a.ws = (unsigned char*)d_ws;
#if MK_COOP
    a.ph_lo = 0; a.ph_hi = N_PHASES;
    void* args[] = {&a};
    hipError_t e = hipLaunchCooperativeKernel((const void*)fwd_kernel, dim3(grid), dim3(NTHREADS), args, LDS_BYTES, stream);
    if (e != hipSuccess) fprintf(stderr, "kernel_launch: cooperative launch failed: %s (grid %d)\n", hipGetErrorString(e), grid);
#else
    for (int ph = 0; ph < N_PHASES; ++ph) { a.ph_lo = ph; a.ph_hi = ph + 1; hipLaunchKernelGGL(fwd_kernel, dim3(grid), dim3(NTHREADS), LDS_BYTES, stream, a); }
#endif
}
```
